# Optimizing an MI355X kernel written in HIP

```python
import math
import jax, jax.numpy as jnp
from jax import lax
import numpy as np

D_MODEL = 1024
BATCH = 8
SEQ = 2048
DEPTH = 1
DEC_BATCH = 32
DEC_SEQ = 4
PAST_LEN = 8192
PAGE_SIZE = 128

D_MIX = D_MODEL
D_ATTN = D_MIX // 2
D_CONV = D_MIX - D_ATTN
N_HEADS = 4
HEAD_DIM = D_ATTN // (2 * N_HEADS)
V_DIM = 2 * HEAD_DIM
CONV_WIDTH = 31
D_FF = 4 * D_MODEL
D_PLE = 256
Q_BLOCK = 128
EPS = 1e-6
N_IN = 3 * D_ATTN + 2 * D_CONV

kernel_name = 'hymba_conformer_diffattn_step'


def rms_norm(x, g):
    xf = x.astype(jnp.float32)
    y = xf * lax.rsqrt(jnp.mean(xf * xf, axis=-1, keepdims=True) + EPS)
    return (y * g.astype(jnp.float32)).astype(x.dtype)


def layer_norm(x, g, b):
    xf = x.astype(jnp.float32)
    mu = jnp.mean(xf, axis=-1, keepdims=True)
    var = jnp.mean(jnp.square(xf - mu), axis=-1, keepdims=True)
    y = (xf - mu) * lax.rsqrt(var + EPS) * g.astype(jnp.float32) + b.astype(jnp.float32)
    return y.astype(x.dtype)


def alibi_slopes():
    return jnp.asarray([2.0 ** (-8.0 * (h + 1) / N_HEADS) for h in range(N_HEADS)], dtype=jnp.float32)


def diff_lambda(lq1, lk1, lq2, lk2, lam_init):
    f = jnp.float32
    return (jnp.exp(jnp.sum(lq1.astype(f) * lk1.astype(f)))
            - jnp.exp(jnp.sum(lq2.astype(f) * lk2.astype(f))) + lam_init)


def diff_attend(q, k, v, q_pos, k_pos, lam):
    s = jnp.einsum('bqhcd,bkhcd->bhcqk', q, k).astype(jnp.float32) * (HEAD_DIM ** -0.5)
    dist = (q_pos[:, None] - k_pos[None, :]).astype(jnp.float32)
    s = s - alibi_slopes()[None, :, None, None, None] * dist
    s = jnp.where(k_pos[None, :] <= q_pos[:, None], s, -jnp.inf)
    pr = jax.nn.softmax(s, axis=-1)
    w = pr[:, :, 0] - lam * pr[:, :, 1]
    return jnp.einsum('bhqk,bkhe->bqhe', w.astype(v.dtype), v)


def causal_depthwise_conv(u_ext, w_dw, b_dw):
    y = lax.conv_general_dilated(u_ext, w_dw[:, None, :], window_strides=(1,), padding='VALID',
                                 dimension_numbers=('NWC', 'WIO', 'NWC'), feature_group_count=D_CONV)
    return y + b_dw


def mixer(xn, lp, lam_init, past_k, past_v, conv_prev):
    B, T, _ = xn.shape
    z = xn @ lp['w_in']
    q = z[..., :D_ATTN].reshape(B, T, N_HEADS, 2, HEAD_DIM)
    k = z[..., D_ATTN:2 * D_ATTN].reshape(B, T, N_HEADS, 2, HEAD_DIM)
    v = z[..., 2 * D_ATTN:3 * D_ATTN].reshape(B, T, N_HEADS, V_DIM)
    a, gt = jnp.split(z[..., 3 * D_ATTN:], 2, axis=-1)
    u = a * jax.nn.sigmoid(gt)
    lam = diff_lambda(lp['lambda_q1'], lp['lambda_k1'], lp['lambda_q2'], lp['lambda_k2'], lam_init)
    if past_k is None:
        nb = T // Q_BLOCK
        qb = jnp.moveaxis(q.reshape(B, nb, Q_BLOCK, N_HEADS, 2, HEAD_DIM), 1, 0)
        k_pos = jnp.arange(T)

        def block(args):
            q_blk, i = args
            return diff_attend(q_blk, k, v, i * Q_BLOCK + jnp.arange(Q_BLOCK), k_pos, lam)

        o = lax.map(block, (qb, jnp.arange(nb)))
        o_attn = jnp.moveaxis(o, 0, 1).reshape(B, T, N_HEADS, V_DIM)
        u_ext = jnp.pad(u, ((0, 0), (CONV_WIDTH - 1, 0), (0, 0)))
    else:
        P = past_k.shape[1]
        k_all = jnp.concatenate([past_k, k], axis=1)
        v_all = jnp.concatenate([past_v, v], axis=1)
        o_attn = diff_attend(q, k_all, v_all, P + jnp.arange(T), jnp.arange(P + T), lam)
        u_ext = jnp.concatenate([conv_prev, u], axis=1)
    conv_state = u_ext[:, -(CONV_WIDTH - 1):]
    y_attn = (rms_norm(o_attn, lp['g_subln']) * (1.0 - lam_init)).reshape(B, T, D_ATTN)
    c = causal_depthwise_conv(u_ext, lp['w_dw'], lp['b_dw'])
    y_conv = jax.nn.silu(layer_norm(c, lp['ln_conv_g'], lp['ln_conv_b']))
    out = jnp.concatenate([y_attn, y_conv], axis=-1) @ lp['w_out']
    return out, k, v, conv_state


def decoder_layer(x, pe, lp, lam_init, past_k, past_v, conv_prev):
    m, k, v, conv_state = mixer(rms_norm(x, lp['g_pre_mix']), lp, lam_init, past_k, past_v, conv_prev)
    h = x + rms_norm(m, lp['g_post_mix'])
    f = jnp.square(jax.nn.relu(rms_norm(h, lp['g_pre_ffn']) @ lp['w_ff1'])) @ lp['w_ff2']
    h = h + rms_norm(f, lp['g_post_ffn'])
    h = h + jax.nn.sigmoid(h @ lp['w_ple_gate']) * (pe @ lp['w_ple'])
    return h, k, v, conv_state


def setup_inputs(seed: int = 0) -> dict:
    key = jax.random.key(seed)
    ks = jax.random.split(key, 32)
    f = jnp.float32
    n_pages = PAST_LEN // PAGE_SIZE
    n_pool = (DEC_BATCH * n_pages * 5) // 4

    def nrm(k, shape, scale):
        return jax.random.normal(k, shape, f) * scale

    def gain(k, shape):
        return 1.0 + 0.02 * jax.random.normal(k, shape, f)

    perm = jax.random.permutation(ks[0], n_pool)[: DEC_BATCH * n_pages]
    page_table = perm.reshape(DEC_BATCH, n_pages).astype(jnp.int32)
    return {
        'x_prompt': nrm(ks[1], (BATCH, SEQ, D_MODEL), 1.0),
        'x_sample': nrm(ks[2], (DEC_BATCH, DEC_SEQ, D_MODEL), 1.0),
        'cache_k': nrm(ks[3], (DEPTH, n_pool, PAGE_SIZE, N_HEADS, 2, HEAD_DIM), 1.0),
        'cache_v': nrm(ks[4], (DEPTH, n_pool, PAGE_SIZE, N_HEADS, V_DIM), 1.0),
        'state_conv': nrm(ks[5], (DEPTH, DEC_BATCH, CONV_WIDTH - 1, D_CONV), 0.5),
        'page_table': page_table,
        'p_prompt': nrm(ks[6], (DEPTH, BATCH, SEQ, D_PLE), 1.0),
        'p_sample': nrm(ks[7], (DEPTH, DEC_BATCH, DEC_SEQ, D_PLE), 1.0),
        'w_in': nrm(ks[8], (DEPTH, D_MODEL, N_IN), D_MODEL ** -0.5),
        'w_out': nrm(ks[9], (DEPTH, D_MIX, D_MODEL), D_MIX ** -0.5),
        'lambda_q1': nrm(ks[10], (DEPTH, HEAD_DIM), 0.1),
        'lambda_k1': nrm(ks[11], (DEPTH, HEAD_DIM), 0.1),
        'lambda_q2': nrm(ks[12], (DEPTH, HEAD_DIM), 0.1),
        'lambda_k2': nrm(ks[13], (DEPTH, HEAD_DIM), 0.1),
        'g_subln': gain(ks[14], (DEPTH, V_DIM)),
        'w_dw': nrm(ks[15], (DEPTH, CONV_WIDTH, D_CONV), CONV_WIDTH ** -0.5),
        'b_dw': nrm(ks[16], (DEPTH, D_CONV), 0.02),
        'ln_conv_g': gain(ks[17], (DEPTH, D_CONV)),
        'ln_conv_b': nrm(ks[18], (DEPTH, D_CONV), 0.02),
        'g_pre_mix': gain(ks[19], (DEPTH, D_MODEL)),
        'g_post_mix': gain(ks[20], (DEPTH, D_MODEL)),
        'g_pre_ffn': gain(ks[21], (DEPTH, D_MODEL)),
        'g_post_ffn': gain(ks[22], (DEPTH, D_MODEL)),
        'w_ff1': nrm(ks[23], (DEPTH, D_MODEL, D_FF), D_MODEL ** -0.5),
        'w_ff2': nrm(ks[24], (DEPTH, D_FF, D_MODEL), D_FF ** -0.5),
        'w_ple': nrm(ks[25], (DEPTH, D_PLE, D_MODEL), D_PLE ** -0.5),
        'w_ple_gate': nrm(ks[26], (DEPTH, D_MODEL, D_MODEL), D_MODEL ** -0.5),
    }


def reference(x_prompt, x_sample, cache_k, cache_v, state_conv, page_table, p_prompt, p_sample,
              w_in, w_out, lambda_q1, lambda_k1, lambda_q2, lambda_k2, g_subln, w_dw, b_dw,
              ln_conv_g, ln_conv_b, g_pre_mix, g_post_mix, g_pre_ffn, g_post_ffn,
              w_ff1, w_ff2, w_ple, w_ple_gate):
    hp, hs = x_prompt, x_sample
    DB = x_sample.shape[0]
    kp_l, vp_l, cp_l, ks_l, vs_l, cs_l = [], [], [], [], [], []
    for l in range(DEPTH):
        lam_init = 0.8 - 0.6 * math.exp(-0.3 * l)
        lp = {
            'w_in': w_in[l], 'w_out': w_out[l],
            'lambda_q1': lambda_q1[l], 'lambda_k1': lambda_k1[l],
            'lambda_q2': lambda_q2[l], 'lambda_k2': lambda_k2[l],
            'g_subln': g_subln[l], 'w_dw': w_dw[l], 'b_dw': b_dw[l],
            'ln_conv_g': ln_conv_g[l], 'ln_conv_b': ln_conv_b[l],
            'g_pre_mix': g_pre_mix[l], 'g_post_mix': g_post_mix[l],
            'g_pre_ffn': g_pre_ffn[l], 'g_post_ffn': g_post_ffn[l],
            'w_ff1': w_ff1[l], 'w_ff2': w_ff2[l],
            'w_ple': w_ple[l], 'w_ple_gate': w_ple_gate[l],
        }
        hp, kp, vp, cp = decoder_layer(hp, p_prompt[l], lp, lam_init, None, None, None)
        past_k = cache_k[l][page_table].reshape(DB, -1, N_HEADS, 2, HEAD_DIM)
        past_v = cache_v[l][page_table].reshape(DB, -1, N_HEADS, V_DIM)
        hs, kn, vn, cn = decoder_layer(hs, p_sample[l], lp, lam_init, past_k, past_v, state_conv[l])
        kp_l.append(kp); vp_l.append(vp); cp_l.append(cp)
        ks_l.append(kn); vs_l.append(vn); cs_l.append(cn)
    k_prompt = jnp.stack(kp_l)
    v_prompt = jnp.stack(vp_l)
    conv_prompt = jnp.stack(cp_l)
    k_sample = jnp.stack(ks_l)
    v_sample = jnp.stack(vs_l)
    conv_sample = jnp.stack(cs_l)
    return (hp, hs, k_prompt, v_prompt, conv_prompt, k_sample, v_sample, conv_sample)
```

```cpp
#include <hip/hip_runtime.h>
#include <cstdio>
#include <cstdint>
#include <cmath>

namespace pg8 {
#define PG8_LAS __attribute__((address_space(3)))
typedef unsigned short bf16_t;
typedef short bf16x8 __attribute__((ext_vector_type(8)));
typedef float f32x4 __attribute__((ext_vector_type(4)));
typedef unsigned u32x4 __attribute__((ext_vector_type(4)));
constexpr int BM = 256, BK = 64, HALF = 128, HTB = HALF * BK * 2  , STAGE_BYTES = 8 * HTB, NXCD = 8, WGM = 8;

__host__ __device__ __forceinline__ int lds_byte(int r, int c) { const int st = (r >> 4) * 2 + (c >> 5), rr = r & 15, cc = c & 31, ob = rr * 64 + cc * 2; return st * 1024 + (ob ^ (((ob >> 9) & 1) << 5)); }
__host__ __device__ __forceinline__ void stage_rc(int b, int& R, int& C) { const int st = b / 1024, sb = b % 1024, swz = sb ^ (((sb >> 9) & 1) << 5); R = (st >> 1) * 16 + swz / 64; C = (st & 1) * 32 + (swz % 64) / 2; }
__host__ __device__ __forceinline__ int perm32(int rho) { const int n = rho >> 4, i = rho & 15; return 8 * (i >> 2) + 4 * n + (i & 3); }

struct Unit { int pm, pn; };
struct Gemm { const bf16_t* A; const bf16_t* Bt; int M, N, K; };

struct StaticOrder {
    int nM, nN, nwg, G, c;
    __host__ __device__ void init(int M, int N, int G_, int c_) { nM = M / BM; nN = N / BM; nwg = nM * nN; G = G_; c = c_; }
    __host__ __device__ bool next(int i, Unit& u) const {
        const long L = (long)i * G + c; if (L >= nwg) return false;
        int wgid = (int)L; { const int q = nwg / NXCD, r = nwg % NXCD, xcd = wgid % NXCD, off = wgid / NXCD; wgid = (xcd < r ? xcd * (q + 1) : r * (q + 1) + (xcd - r) * q) + off; }
        const int nig = WGM * nN, gid = wgid / nig, fm = gid * WGM, gsz = (nM - fm) < WGM ? (nM - fm) : WGM;
        u.pm = fm + ((wgid % nig) % gsz); u.pn = (wgid % nig) / gsz; return true;
    }
    __device__ __forceinline__ void a_ready(const Unit&) const {}
    __device__ __forceinline__ void done(const Unit&) const {}
};


__device__ __forceinline__ unsigned cvt_pk_bf16(float lo, float hi) { unsigned r; asm volatile("v_cvt_pk_bf16_f32 %0, %1, %2" : "=v"(r) : "v"(lo), "v"(hi)); return r; }
typedef float f32x2 __attribute__((ext_vector_type(2)));

template <class Epi, class Sched, bool ALIGN_EPI = false, bool SP2 = false>
__device__ __forceinline__ void gemm_phase(PG8_LAS unsigned char* lds, const Gemm g, const Sched& S, const Epi& E) {
    int tid_ = threadIdx.x; asm volatile("" : "+v"(tid_));
    const int tid = tid_, wid = __builtin_amdgcn_readfirstlane(tid >> 6), lane = tid & 63, wr = wid >> 2, wc = wid & 3, fr = lane & 15, fq = lane >> 4;
    const int K = g.K, nt = K / BK;
    unsigned voffA[2], voffB[2];
#pragma unroll
    for (int i = 0; i < 2; ++i) { int R, C; stage_rc(tid * 16 + i * 8192, R, C); const int Rb = Epi::PERM ? ((R & ~31) + perm32(R & 31)) : R;
        voffA[i] = (unsigned)(R * K + C) * 2u; voffB[i] = (unsigned)(Rb * K + C) * 2u; }
    const size_t kstep = (size_t)(BK * 2);
    const size_t hstep = (size_t)HALF * K * 2;
    const size_t tstep = 2 * hstep;
    const unsigned ldsw = (unsigned)wid * 1024u;
    const int aoff = lds_byte(wr * 64 + fr, fq * 8), boff = lds_byte(wc * 32 + fr, fq * 8);
#define PG8_SA(b, h) (((b) * 2 + (h)) * HTB)
#define PG8_SB(b, h) ((4 + (b) * 2 + (h)) * HTB)
#define PG8_STAGE(bufoff, gbase, voff) do { _Pragma("unroll") for (int _i = 0; _i < 2; ++_i) \
        __builtin_amdgcn_global_load_lds((const unsigned*)((const char*)(gbase) + (voff)[_i]), (PG8_LAS unsigned*)(lds + (bufoff) + ldsw + _i * 8192), 16, 0, 0); } while (0)
#define PG8_LDA(dst, b, h) do { _Pragma("unroll") for (int m = 0; m < 4; ++m) _Pragma("unroll") for (int k = 0; k < 2; ++k) dst[m][k] = *(const PG8_LAS bf16x8*)(lds + PG8_SA(b, h) + aoff + m * 2048 + k * 1024); } while (0)
#define PG8_LDB(dst, b, h) do { _Pragma("unroll") for (int n = 0; n < 2; ++n) _Pragma("unroll") for (int k = 0; k < 2; ++k) dst[n][k] = *(const PG8_LAS bf16x8*)(lds + PG8_SB(b, h) + boff + n * 2048 + k * 1024); } while (0)
#define PG8_MMA(ai, bj, At, Bt) do { __builtin_amdgcn_s_setprio(1); _Pragma("unroll") for (int m = 0; m < 4; ++m) _Pragma("unroll") for (int n = 0; n < 2; ++n) _Pragma("unroll") for (int k = 0; k < 2; ++k) \
        acc[ai][bj][m][n] = __builtin_amdgcn_mfma_f32_16x16x32_bf16(Bt[n][k], At[m][k], acc[ai][bj][m][n], 0, 0, 0); __builtin_amdgcn_s_setprio(0); } while (0)
#define PG8_WAIT_V(n) asm volatile("s_waitcnt vmcnt(" #n ")" ::: "memory")
#define PG8_WAIT_L(n) asm volatile("s_waitcnt lgkmcnt(" #n ")" ::: "memory")
#define PG8_BAR __builtin_amdgcn_s_barrier()
#define PG8_SCHED __builtin_amdgcn_sched_barrier(0)
    Unit cur, nxt; int ui = 0;
    if (!S.next(0, cur)) return;
    f32x4 acc[2][2][4][2];
#pragma unroll
    for (int a = 0; a < 2; ++a)
#pragma unroll
        for (int b = 0; b < 2; ++b)
#pragma unroll
            for (int m = 0; m < 4; ++m)
#pragma unroll
                for (int n = 0; n < 2; ++n) acc[a][b][m][n] = (f32x4){0.f, 0.f, 0.f, 0.f};
    bf16x8 At[4][2], B0[2][2], B1[2][2];
    const char* cA = (const char*)g.A + (size_t)cur.pm * tstep; const char* cB = (const char*)g.Bt + (size_t)cur.pn * tstep;
    S.a_ready(cur);
    if constexpr (SP2) {
        PG8_STAGE(PG8_SB(0, 0), cB, voffB); PG8_STAGE(PG8_SB(0, 1), cB + hstep, voffB); PG8_STAGE(PG8_SA(0, 0), cA, voffA); PG8_STAGE(PG8_SA(0, 1), cA + hstep, voffA);
        if (wr == 1) PG8_BAR;
        PG8_WAIT_V(2); PG8_BAR;
        PG8_STAGE(PG8_SB(1, 0), cB + kstep, voffB); PG8_STAGE(PG8_SA(1, 0), cA + kstep, voffA); PG8_STAGE(PG8_SB(1, 1), cB + hstep + kstep, voffB);
        PG8_WAIT_V(6); PG8_BAR;
    } else {
        PG8_STAGE(PG8_SB(0, 0), cB, voffB); PG8_STAGE(PG8_SA(0, 0), cA, voffA); PG8_STAGE(PG8_SB(0, 1), cB + hstep, voffB); PG8_STAGE(PG8_SA(0, 1), cA + hstep, voffA);
        if (wr == 1) PG8_BAR;
        PG8_WAIT_V(4); PG8_BAR;
        PG8_STAGE(PG8_SB(1, 0), cB + kstep, voffB); PG8_STAGE(PG8_SA(1, 0), cA + kstep, voffA); PG8_STAGE(PG8_SB(1, 1), cB + hstep + kstep, voffB);
        PG8_WAIT_V(6); PG8_BAR;
    }
    for (;;) {
        const bool has_next = S.next(ui + 1, nxt);
        const char* nA = has_next ? (const char*)g.A + (size_t)nxt.pm * tstep : cA; const char* nB = has_next ? (const char*)g.Bt + (size_t)nxt.pn * tstep : cB;
        for (int t = 0; t < nt; t += 2) {
            const bool last = (t == nt - 2);
            const char* a1 = cA + (size_t)(t + 1) * kstep;
            const char* a2 = last ? nA : cA + (size_t)(t + 2) * kstep; const char* b2 = last ? nB : cB + (size_t)(t + 2) * kstep;
            const char* a3 = a2 + kstep; const char* b3 = b2 + kstep;
            if (last && has_next) S.a_ready(nxt);
            if constexpr (SP2) {
            PG8_LDB(B0, 0, 0); PG8_LDB(B1, 0, 1); PG8_SCHED; PG8_LDA(At, 0, 0); PG8_STAGE(PG8_SA(1, 1), a1 + hstep, voffA);
            PG8_WAIT_V(8); PG8_WAIT_L(0); PG8_BAR; PG8_MMA(0, 0, At, B0); PG8_MMA(0, 1, At, B1); PG8_BAR; PG8_SCHED;
            PG8_LDA(At, 0, 1); PG8_STAGE(PG8_SB(0, 0), b2, voffB); PG8_STAGE(PG8_SB(0, 1), b2 + hstep, voffB); PG8_STAGE(PG8_SA(0, 0), a2, voffA);
            PG8_WAIT_V(8); PG8_WAIT_L(0); PG8_BAR; PG8_MMA(1, 0, At, B0); PG8_MMA(1, 1, At, B1); PG8_BAR; PG8_SCHED;
            PG8_LDB(B0, 1, 0); PG8_LDB(B1, 1, 1); PG8_SCHED; PG8_LDA(At, 1, 0); PG8_STAGE(PG8_SA(0, 1), a2 + hstep, voffA);
            PG8_WAIT_V(8); PG8_WAIT_L(0); PG8_BAR; PG8_MMA(0, 0, At, B0); PG8_MMA(0, 1, At, B1); PG8_BAR; PG8_SCHED;
            PG8_LDA(At, 1, 1); PG8_STAGE(PG8_SB(1, 0), b3, voffB); PG8_STAGE(PG8_SB(1, 1), b3 + hstep, voffB); PG8_STAGE(PG8_SA(1, 0), a3, voffA);
            PG8_WAIT_V(8); PG8_WAIT_L(0); PG8_BAR; PG8_MMA(1, 0, At, B0); PG8_MMA(1, 1, At, B1); PG8_BAR; PG8_SCHED;
            } else {
            PG8_LDB(B0, 0, 0); PG8_SCHED; PG8_LDA(At, 0, 0); PG8_STAGE(PG8_SA(1, 1), a1 + hstep, voffA);
            PG8_WAIT_L(8); PG8_BAR; PG8_WAIT_L(0); PG8_MMA(0, 0, At, B0); PG8_BAR; PG8_SCHED;
            PG8_LDB(B1, 0, 1); PG8_STAGE(PG8_SB(0, 0), b2, voffB);
            PG8_BAR; PG8_WAIT_L(0); PG8_MMA(0, 1, At, B1); PG8_BAR;
            PG8_LDA(At, 0, 1); PG8_STAGE(PG8_SA(0, 0), a2, voffA);
            PG8_BAR; PG8_WAIT_L(0); PG8_MMA(1, 0, At, B0); PG8_BAR; PG8_SCHED;
            PG8_STAGE(PG8_SB(0, 1), b2 + hstep, voffB);
            PG8_WAIT_V(6); PG8_BAR; PG8_MMA(1, 1, At, B1); PG8_BAR;
            PG8_LDB(B0, 1, 0); PG8_SCHED; PG8_LDA(At, 1, 0); PG8_STAGE(PG8_SA(0, 1), a2 + hstep, voffA);
            PG8_WAIT_L(8); PG8_BAR; PG8_WAIT_L(0); PG8_MMA(0, 0, At, B0); PG8_BAR; PG8_SCHED;
            PG8_LDB(B1, 1, 1); PG8_STAGE(PG8_SB(1, 0), b3, voffB);
            PG8_BAR; PG8_WAIT_L(0); PG8_MMA(0, 1, At, B1); PG8_BAR;
            PG8_LDA(At, 1, 1); PG8_STAGE(PG8_SA(1, 0), a3, voffA);
            PG8_BAR; PG8_WAIT_L(0); PG8_MMA(1, 0, At, B0); PG8_BAR; PG8_SCHED;
            PG8_STAGE(PG8_SB(1, 1), b3 + hstep, voffB);
            PG8_WAIT_V(6); PG8_BAR; PG8_MMA(1, 1, At, B1); PG8_BAR;
            }
        }
        if constexpr (ALIGN_EPI) { if (wr == 0) PG8_BAR; }
        if constexpr (!Epi::AFTER_DRAIN) { E(acc, cur, wr, wc, fr, fq); S.done(cur); }
        if (!has_next) break;
#pragma unroll
        for (int a = 0; a < 2; ++a)
#pragma unroll
            for (int b = 0; b < 2; ++b)
#pragma unroll
                for (int m = 0; m < 4; ++m)
#pragma unroll
                    for (int n = 0; n < 2; ++n) acc[a][b][m][n] = (f32x4){0.f, 0.f, 0.f, 0.f};
        cur = nxt; cA = nA; cB = nB; ++ui;
        if constexpr (ALIGN_EPI) { if (wr == 1) PG8_BAR; }
    }
    PG8_WAIT_V(0);
    if constexpr (!ALIGN_EPI) { if (wr == 0) PG8_BAR; }
    PG8_BAR;
    if constexpr (Epi::AFTER_DRAIN) { E.fused(acc, cur, wr, wc, fr, fq, lds, wid, lane); S.done(cur); }
#undef PG8_SA
#undef PG8_SB
#undef PG8_STAGE
#undef PG8_LDA
#undef PG8_LDB
#undef PG8_MMA
#undef PG8_WAIT_V
#undef PG8_WAIT_L
#undef PG8_BAR
#undef PG8_SCHED
}
}

#define GAS __attribute__((address_space(1)))
#define LAS __attribute__((address_space(3)))
typedef unsigned short bf16;
typedef unsigned v4u __attribute__((ext_vector_type(4)));
typedef float f32x4 __attribute__((ext_vector_type(4)));
typedef short bf16x8 __attribute__((ext_vector_type(8)));
typedef GAS unsigned gu32;
typedef GAS unsigned long long gu64;
#define RLX_AGENT __ATOMIC_RELAXED, __HIP_MEMORY_SCOPE_AGENT
#define LDS_WAIT() asm volatile("s_waitcnt lgkmcnt(0)" ::: "memory")
#define VM_WAIT() asm volatile("s_waitcnt vmcnt(0)" ::: "memory")
__device__ __forceinline__ unsigned long long rt() { return __builtin_amdgcn_s_memrealtime(); }
__device__ __forceinline__ unsigned f2bf(float f) { unsigned u = __builtin_bit_cast(unsigned, f); return (u + 0x7fffu + ((u >> 16) & 1u)) >> 16; }
__device__ __forceinline__ unsigned pk2(float lo, float hi) { return f2bf(lo) | (f2bf(hi) << 16); }

#define XB_TMO      128
#define XB_XCNT(j)  (256  + 64 * (j))
#define XB_XSUB(j)  (1280 + 64 * (j))
#define XB_XGEN(j)  (2304 + 64 * (j))
#define XB_TOP      3328
#define XB_TOPGEN   3392
#define XCD_BAR_WORDS 3456
#define XB_SPIN_CAP (1u << 18)

__device__ __forceinline__ unsigned xb_ld(unsigned* p)              { return __hip_atomic_load(p, __ATOMIC_RELAXED, __HIP_MEMORY_SCOPE_AGENT); }
__device__ __forceinline__ unsigned xb_add(unsigned* p, unsigned v) { return __hip_atomic_fetch_add(p, v, __ATOMIC_RELAXED, __HIP_MEMORY_SCOPE_AGENT); }
__device__ __forceinline__ unsigned xb_xcc_id() { return (unsigned)__builtin_amdgcn_s_getreg((3 << 11) | 20) & 0xFu; }
#define XB_SPIN(cond, bar) do { unsigned _sp = 0; while (cond) { __builtin_amdgcn_s_sleep(1); \
    if ((++_sp & 255u) == 0u) { if (xb_ld(&(bar)[XB_TMO])) break; if (_sp > XB_SPIN_CAP) { atomicAdd(&(bar)[XB_TMO], 1u); break; } } } } while (0)

struct XcdBarrier {
    unsigned* bar; unsigned x;
    volatile LAS unsigned* st;
};

__device__ __forceinline__ XcdBarrier xcd_barrier_post(unsigned* bar, volatile LAS unsigned* st) {
    XcdBarrier b; b.bar = bar; b.x = xb_xcc_id(); b.st = st;
    if (threadIdx.x == 0) (void)xb_add(&bar[XB_XCNT(b.x)], 1u);
    return b;
}
__device__ __forceinline__ void xcd_barrier_complete(unsigned* bar, unsigned x, unsigned& nloc, unsigned& nx) {
    const unsigned G = gridDim.x * gridDim.y * gridDim.z;
    unsigned sum, cnt, mine, sp = 0u;
    for (;;) {
        sum = 0u; cnt = 0u; mine = 0u;
#pragma unroll
        for (unsigned j = 0; j < 16; ++j) { const unsigned c = xb_ld(&bar[XB_XCNT(j)]); sum += c; cnt += (c > 0u) ? 1u : 0u; mine = (j == x) ? c : mine; }
        if (sum == G) break;
        __builtin_amdgcn_s_sleep(1);
        if ((++sp & 255u) == 0u) { if (xb_ld(&bar[XB_TMO])) break; if (sp > XB_SPIN_CAP) { atomicAdd(&bar[XB_TMO], 1u); break; } }
    }
    nloc = mine > 0u ? mine : 1u; nx = cnt > 0u ? cnt : 1u;
}

__device__ __forceinline__ void xcd_barrier(const XcdBarrier& b) {
    asm volatile("s_waitcnt vmcnt(0)" ::: "memory");
    __syncthreads();
    if (threadIdx.x == 0) {
        unsigned* bar = b.bar;
        __builtin_amdgcn_s_waitcnt(0);
        unsigned nloc = b.st[0], nx = b.st[1];
        if (nloc == 0u) { xcd_barrier_complete(bar, b.x, nloc, nx); b.st[0] = nloc; b.st[1] = nx; }
        const unsigned old = xb_add(&bar[XB_XSUB(b.x)], 1u);
        const unsigned gen = old / nloc;
        if (old + 1u == (gen + 1u) * nloc) {
            __builtin_amdgcn_fence(__ATOMIC_RELEASE, "agent");
            asm volatile("s_waitcnt vmcnt(0)" ::: "memory");
            const unsigned og = xb_add(&bar[XB_TOP], 1u);
            const unsigned tg = og / nx;
            if (og + 1u == (tg + 1u) * nx) xb_add(&bar[XB_TOPGEN], 1u);
            else XB_SPIN(xb_ld(&bar[XB_TOPGEN]) == tg, bar);
            __builtin_amdgcn_fence(__ATOMIC_ACQUIRE, "agent");
            xb_add(&bar[XB_XGEN(b.x)], 1u);
            asm volatile("s_waitcnt vmcnt(0)" ::: "memory");
        } else {
            XB_SPIN(xb_ld(&bar[XB_XGEN(b.x)]) == gen, bar);
            __builtin_amdgcn_fence(__ATOMIC_ACQUIRE, "agent");
            asm volatile("s_waitcnt vmcnt(0)" ::: "memory");
        }
    }
    __syncthreads();
}


constexpr int NWAVES = 8;
constexpr int DM = 1024, NB = 8, SEQ = 2048, DB = 32, DS = 4, PAST = 8192, PAGE = 128, NPAGES = 64;
constexpr int DA = 512, DC = 512, NH = 4, HD = 64, VD = 128, CW = 31, DFF = 4096, DPLE = 256, NIN = 2560;
constexpr int MP = NB * SEQ;
constexpr int MS = DB * DS;
constexpr int MR = MP + MS;
constexpr int MT = 16640;
constexpr float EPS = 1e-6f;
constexpr float LOG2E = 1.4426950408889634f;
constexpr float C2 = 0.125f * LOG2E;
constexpr float LAM_INIT = 0.2f;
constexpr size_t O_YP = 0, O_YS = O_YP + (size_t)MP * DM, O_KP = O_YS + (size_t)MS * DM, O_VP = O_KP + (size_t)MP * DA,
                 O_CP = O_VP + (size_t)MP * DA, O_KS = O_CP + (size_t)NB * 30 * DC, O_VS = O_KS + (size_t)MS * DA, O_CS = O_VS + (size_t)MS * DA,
                 O_END = O_CS + (size_t)DB * 30 * DC;
static_assert(O_END == 34430976, "output size");
constexpr size_t MiB = 1u << 20;
constexpr size_t al1(size_t x) { return (x + MiB - 1) / MiB * MiB; }
constexpr size_t WS_CTL = 0, CTL_ZERO_BYTES = 1 * MiB;
constexpr size_t WS_WIN = 1 * MiB;
constexpr size_t WS_WOUT = WS_WIN + al1((size_t)NIN * DM * 2);
constexpr size_t WS_WFF1 = WS_WOUT + al1((size_t)DM * DM * 2);
constexpr size_t WS_WFF2 = WS_WFF1 + al1((size_t)DFF * DM * 2);
constexpr size_t WS_WGATE = WS_WFF2 + al1((size_t)DFF * DM * 2);
constexpr size_t WS_WPLE = WS_WGATE + al1((size_t)DM * DM * 2);
constexpr size_t WS_XN = WS_WPLE + al1((size_t)DM * DPLE * 2);
constexpr size_t WS_Q = WS_XN + al1((size_t)MT * DM * 2);
constexpr size_t WS_K = WS_Q + al1((size_t)MT * DA * 2);
constexpr size_t WS_V = WS_K + al1((size_t)MT * DA * 2);
constexpr size_t WS_U = WS_V + al1((size_t)MT * DA * 2);
constexpr size_t WS_Y2 = WS_U + al1((size_t)MT * DC * 2);
constexpr size_t WS_MM = WS_Y2 + al1((size_t)MT * DM * 2);
constexpr size_t WS_H = WS_MM + al1((size_t)MT * DM * 4);
constexpr size_t WS_HN = WS_H + al1((size_t)MT * DM * 4);
constexpr size_t WS_HH = WS_HN + al1((size_t)MT * DM * 2);
constexpr size_t WS_FF = WS_HH + al1((size_t)MT * DFF * 2);
constexpr size_t WS_H2 = WS_FF + al1((size_t)MT * DM * 4);
constexpr size_t WS_H2B = WS_H2 + al1((size_t)MT * DM * 4);
constexpr size_t WS_PE = WS_H2B + al1((size_t)MT * DM * 2);
constexpr size_t WS_E = WS_PE + al1((size_t)MT * DPLE * 2);
constexpr size_t WS_QS = WS_E + al1((size_t)MT * DM * 2);
constexpr int DSPLIT = 2, PREC = 132;
constexpr size_t WS_DP = WS_QS + al1((size_t)MS * DA * 4);
constexpr size_t WS_END = WS_DP + al1((size_t)DB * NH * DSPLIT * 2 * DS * PREC * 4);
constexpr int CW_TMO = 0, CW_CODE = 1, CW_BAR = 4096;

constexpr int RING_OFF = 0, RING_BYTES = 131072;
constexpr int LDSCTL_OFF = RING_BYTES, MISC_OFF = LDSCTL_OFF + 320;
constexpr int LDS_BYTES = 147456;
static_assert(MISC_OFF + 128 <= LDS_BYTES, "LDS map");


__device__ __forceinline__ float sigmoidf_fast(float x) { return __builtin_amdgcn_rcpf(1.0f + __builtin_amdgcn_exp2f(-x * LOG2E)); }
__device__ __forceinline__ v4u pack8(const f32x4& a, const f32x4& b) { v4u w; w.x = pg8::cvt_pk_bf16(a[0], a[1]); w.y = pg8::cvt_pk_bf16(a[2], a[3]); w.z = pg8::cvt_pk_bf16(b[0], b[1]); w.w = pg8::cvt_pk_bf16(b[2], b[3]); return w; }

struct EpiIn {
    static constexpr bool PERM = true, AFTER_DRAIN = false;
    bf16* Qb; bf16* Kb; bf16* Vb; bf16* Ub; float* QS; float* out;
    __device__ __forceinline__ void operator()(const f32x4 (&acc)[2][2][4][2], const pg8::Unit& u, int wr, int wc, int fr, int fq) const {
        const int pn = u.pn;
        const int rbase = u.pm * 256 + wr * 64 + fr;
        const int cl = wc * 32 + 8 * fq;
        if (pn < 6) {
            const int kind = pn >> 1, colh = (pn & 1) * 256;
#pragma unroll
            for (int ai = 0; ai < 2; ++ai)
#pragma unroll
                for (int m = 0; m < 4; ++m) {
                    const int row = rbase + ai * 128 + m * 16;
                    if (row < MR) {
#pragma unroll
                        for (int bj = 0; bj < 2; ++bj) {
                            const int col = colh + bj * 128 + cl;
                            f32x4 v0 = acc[ai][bj][m][0], v1 = acc[ai][bj][m][1];
                            if (kind == 0) {
                                v0 = v0 * C2; v1 = v1 * C2;
                                *(v4u*)(Qb + (size_t)row * DA + col) = pack8(v0, v1);
                                if (row >= MP) { float* q = QS + (size_t)(row - MP) * DA + col; *(f32x4*)q = v0; *(f32x4*)(q + 4) = v1; }
                            } else {
                                bf16* B = (kind == 1) ? Kb : Vb;
                                *(v4u*)(B + (size_t)row * DA + col) = pack8(v0, v1);
                                float* o = (row < MP) ? out + (kind == 1 ? O_KP : O_VP) + (size_t)row * DA + col
                                                      : out + (kind == 1 ? O_KS : O_VS) + (size_t)(row - MP) * DA + col;
                                *(f32x4*)o = v0; *(f32x4*)(o + 4) = v1;
                            }
                        }
                    }
                }
        } else {
            const int ch = (pn - 6) * 128 + cl;
#pragma unroll
            for (int ai = 0; ai < 2; ++ai)
#pragma unroll
                for (int m = 0; m < 4; ++m) {
                    const int row = rbase + ai * 128 + m * 16;
                    if (row < MR) {
                        f32x4 u0, u1;
#pragma unroll
                        for (int i = 0; i < 4; ++i) { u0[i] = acc[ai][0][m][0][i] * sigmoidf_fast(acc[ai][1][m][0][i]); u1[i] = acc[ai][0][m][1][i] * sigmoidf_fast(acc[ai][1][m][1][i]); }
                        *(v4u*)(Ub + (size_t)row * DC + ch) = pack8(u0, u1);
                        float* cs = nullptr;
                        if (row < MP) { const int t = row & (SEQ - 1); if (t >= SEQ - 30) cs = out + O_CP + ((size_t)(row >> 11) * 30 + (t - (SEQ - 30))) * DC + ch; }
                        else { const int r = row - MP; cs = out + O_CS + ((size_t)(r >> 2) * 30 + 26 + (r & 3)) * DC + ch; }
                        if (cs) { *(f32x4*)cs = u0; *(f32x4*)(cs + 4) = u1; }
                    }
                }
        }
    }
};
struct EpiF32 {
    static constexpr bool PERM = true, AFTER_DRAIN = false;
    float* O; int ldc;
    __device__ __forceinline__ void operator()(const f32x4 (&acc)[2][2][4][2], const pg8::Unit& u, int wr, int wc, int fr, int fq) const {
        const int rbase = u.pm * 256 + wr * 64 + fr, cb = u.pn * 256 + wc * 32 + 8 * fq;
#pragma unroll
        for (int ai = 0; ai < 2; ++ai)
#pragma unroll
            for (int m = 0; m < 4; ++m) { float* rp = O + (size_t)(rbase + ai * 128 + m * 16) * ldc + cb;
#pragma unroll
                for (int bj = 0; bj < 2; ++bj) { *(f32x4*)(rp + bj * 128) = acc[ai][bj][m][0]; *(f32x4*)(rp + bj * 128 + 4) = acc[ai][bj][m][1]; } }
    }
};
template <int ACT> struct EpiB16 {
    static constexpr bool PERM = true, AFTER_DRAIN = false;
    bf16* O; int ldc;
    __device__ __forceinline__ void operator()(const f32x4 (&acc)[2][2][4][2], const pg8::Unit& u, int wr, int wc, int fr, int fq) const {
        const int rbase = u.pm * 256 + wr * 64 + fr, cb = u.pn * 256 + wc * 32 + 8 * fq;
#pragma unroll
        for (int ai = 0; ai < 2; ++ai)
#pragma unroll
            for (int m = 0; m < 4; ++m) { bf16* rp = O + (size_t)(rbase + ai * 128 + m * 16) * ldc + cb;
#pragma unroll
                for (int bj = 0; bj < 2; ++bj) { f32x4 v0 = acc[ai][bj][m][0], v1 = acc[ai][bj][m][1];
                    if (ACT == 1) {
#pragma unroll
                        for (int i = 0; i < 4; ++i) { const float a = fmaxf(v0[i], 0.f), b = fmaxf(v1[i], 0.f); v0[i] = a * a; v1[i] = b * b; } }
                    *(v4u*)(rp + bj * 128) = pack8(v0, v1); } }
    }
};
struct EpiGate {
    static constexpr bool PERM = true, AFTER_DRAIN = false;
    const float* H2; const bf16* E; float* out;
    __device__ __forceinline__ void operator()(const f32x4 (&acc)[2][2][4][2], const pg8::Unit& u, int wr, int wc, int fr, int fq) const {
        const int rbase = u.pm * 256 + wr * 64 + fr, cb = u.pn * 256 + wc * 32 + 8 * fq;
#pragma unroll
        for (int ai = 0; ai < 2; ++ai)
#pragma unroll
            for (int m = 0; m < 4; ++m) {
                const int row = rbase + ai * 128 + m * 16;
                if (row < MR) {
                    float* op = (row < MP) ? out + O_YP + (size_t)row * DM + cb : out + O_YS + (size_t)(row - MP) * DM + cb;
#pragma unroll
                    for (int bj = 0; bj < 2; ++bj) {
                        const f32x4 h0 = *(const f32x4*)(H2 + (size_t)row * DM + cb + bj * 128), h1 = *(const f32x4*)(H2 + (size_t)row * DM + cb + bj * 128 + 4);
                        const v4u ev = *(const v4u*)(E + (size_t)row * DM + cb + bj * 128);
                        f32x4 e0, e1;
                        e0[0] = __uint_as_float(ev.x << 16); e0[1] = __uint_as_float(ev.x & 0xffff0000u); e0[2] = __uint_as_float(ev.y << 16); e0[3] = __uint_as_float(ev.y & 0xffff0000u);
                        e1[0] = __uint_as_float(ev.z << 16); e1[1] = __uint_as_float(ev.z & 0xffff0000u); e1[2] = __uint_as_float(ev.w << 16); e1[3] = __uint_as_float(ev.w & 0xffff0000u);
                        f32x4 y0, y1;
#pragma unroll
                        for (int i = 0; i < 4; ++i) { y0[i] = h0[i] + sigmoidf_fast(acc[ai][bj][m][0][i]) * e0[i]; y1[i] = h1[i] + sigmoidf_fast(acc[ai][bj][m][1][i]) * e1[i]; }
                        *(f32x4*)(op + bj * 128) = y0; *(f32x4*)(op + bj * 128 + 4) = y1;
                    }
                }
            }
    }
};


struct Frame {
    LAS unsigned char* lds;
    volatile LAS unsigned* MISC;
    gu32* ctl;
    int tid, lane, wave;
    int vcu, G;
};
__device__ __forceinline__ float wave_sum(float v) {
#pragma unroll
    for (int o = 1; o < 64; o <<= 1) v += __shfl_xor(v, o);
    return v;
}
__device__ __forceinline__ float wave_max(float v) {
#pragma unroll
    for (int o = 1; o < 64; o <<= 1) v = fmaxf(v, __shfl_xor(v, o));
    return v;
}
__device__ __forceinline__ float bf_lo(unsigned w) { return __uint_as_float(w << 16); }
__device__ __forceinline__ float bf_hi(unsigned w) { return __uint_as_float(w & 0xffff0000u); }
__device__ __forceinline__ float alibi_slope2(int h) { return LOG2E * (h == 0 ? 0.25f : h == 1 ? 0.0625f : h == 2 ? 0.015625f : 0.00390625f); }
__device__ __forceinline__ float diff_lambda(const float* q1, const float* k1, const float* q2, const float* k2, int lane) {
    const float a = wave_sum(q1[lane] * k1[lane]), b = wave_sum(q2[lane] * k2[lane]);
    return __expf(a) - __expf(b) + LAM_INIT;
}

__device__ __forceinline__ void p0_transpose_item(const float* W, int K, int N, bf16* WT, int k0, int n0, int drow0, LAS float* scr, int lane) {
#pragma unroll 8
    for (int i = 0; i < 32; ++i) { const int kk = 2 * i + (lane >> 5); scr[kk * 33 + (lane & 31)] = W[(size_t)(k0 + kk) * N + n0 + (lane & 31)]; }
    LDS_WAIT(); asm volatile("" ::: "memory");
    const int c = lane & 7;
#pragma unroll
    for (int j = 0; j < 4; ++j) { const int n = (lane >> 3) + 8 * j; const LAS float* s = scr + (8 * c) * 33 + n;
        v4u o; o.x = pk2(s[0 * 33], s[1 * 33]); o.y = pk2(s[2 * 33], s[3 * 33]); o.z = pk2(s[4 * 33], s[5 * 33]); o.w = pk2(s[6 * 33], s[7 * 33]);
        *(GAS v4u*)(WT + (size_t)(drow0 + n) * K + k0 + 8 * c) = o; }
    LDS_WAIT(); asm volatile("" ::: "memory");
}
__device__ __forceinline__ int win_dest_row(int n0) {
    if (n0 < 3 * DA) return n0;
    if (n0 < 3 * DA + DC) { const int ch = n0 - 3 * DA; return 3 * DA + (ch >> 7) * 256 + (ch & 127); }
    const int ch = n0 - 3 * DA - DC; return 3 * DA + (ch >> 7) * 256 + 128 + (ch & 127);
}
__device__ __forceinline__ const float* x_row(const float* xp, const float* xs, int m) { return m < MP ? xp + (size_t)m * DM : xs + (size_t)(m - MP) * DM; }
__device__ __forceinline__ void rms_row_to_bf16(const float* xrow, const float* g, bf16* orow, int lane) {
    const GAS f32x4* xr = (const GAS f32x4*)xrow + lane; const GAS f32x4* gr = (const GAS f32x4*)g + lane;
    f32x4 v[4]; float s = 0.f;
#pragma unroll
    for (int j = 0; j < 4; ++j) { v[j] = xr[64 * j]; s += (v[j].x * v[j].x + v[j].y * v[j].y) + (v[j].z * v[j].z + v[j].w * v[j].w); }
    const float r = 1.f / sqrtf(wave_sum(s) * (1.f / DM) + EPS);
    GAS unsigned long long* o8 = (GAS unsigned long long*)orow + lane;
#pragma unroll
    for (int j = 0; j < 4; ++j) { const f32x4 gg = gr[64 * j]; o8[64 * j] = (unsigned long long)pk2(v[j].x * r * gg.x, v[j].y * r * gg.y) | ((unsigned long long)pk2(v[j].z * r * gg.z, v[j].w * r * gg.w) << 32); }
}
__device__ __forceinline__ void post_mix_row(const float* mmrow, const float* xrow, const float* g1, const float* g2, float* hrow, bf16* hnrow, int lane) {
    const GAS f32x4* mr = (const GAS f32x4*)mmrow + lane; const GAS f32x4* xr = (const GAS f32x4*)xrow + lane;
    const GAS f32x4* g1r = (const GAS f32x4*)g1 + lane; const GAS f32x4* g2r = (const GAS f32x4*)g2 + lane;
    f32x4 v[4]; float s = 0.f;
#pragma unroll
    for (int j = 0; j < 4; ++j) { v[j] = mr[64 * j]; s += (v[j].x * v[j].x + v[j].y * v[j].y) + (v[j].z * v[j].z + v[j].w * v[j].w); }
    const float r1 = 1.f / sqrtf(wave_sum(s) * (1.f / DM) + EPS);
    float s2 = 0.f;
#pragma unroll
    for (int j = 0; j < 4; ++j) { v[j] = xr[64 * j] + v[j] * r1 * g1r[64 * j]; s2 += (v[j].x * v[j].x + v[j].y * v[j].y) + (v[j].z * v[j].z + v[j].w * v[j].w); }
    const float r2 = 1.f / sqrtf(wave_sum(s2) * (1.f / DM) + EPS);
    GAS f32x4* ho = (GAS f32x4*)hrow + lane; GAS unsigned long long* o8 = (GAS unsigned long long*)hnrow + lane;
#pragma unroll
    for (int j = 0; j < 4; ++j) { ho[64 * j] = v[j]; const f32x4 gg = g2r[64 * j];
        o8[64 * j] = (unsigned long long)pk2(v[j].x * r2 * gg.x, v[j].y * r2 * gg.y) | ((unsigned long long)pk2(v[j].z * r2 * gg.z, v[j].w * r2 * gg.w) << 32); }
}
__device__ __forceinline__ void post_ffn_row(const float* ffrow, const float* hrow, const float* g, float* h2row, bf16* h2brow, int lane) {
    const GAS f32x4* fr = (const GAS f32x4*)ffrow + lane; const GAS f32x4* hr = (const GAS f32x4*)hrow + lane; const GAS f32x4* gr = (const GAS f32x4*)g + lane;
    f32x4 v[4]; float s = 0.f;
#pragma unroll
    for (int j = 0; j < 4; ++j) { v[j] = fr[64 * j]; s += (v[j].x * v[j].x + v[j].y * v[j].y) + (v[j].z * v[j].z + v[j].w * v[j].w); }
    const float r1 = 1.f / sqrtf(wave_sum(s) * (1.f / DM) + EPS);
    GAS f32x4* ho = (GAS f32x4*)h2row + lane; GAS unsigned long long* o8 = (GAS unsigned long long*)h2brow + lane;
#pragma unroll
    for (int j = 0; j < 4; ++j) { const f32x4 y = hr[64 * j] + v[j] * r1 * gr[64 * j]; ho[64 * j] = y;
        o8[64 * j] = (unsigned long long)pk2(y.x, y.y) | ((unsigned long long)pk2(y.z, y.w) << 32); }
}
__device__ __forceinline__ void cvt_row256(const float* src, bf16* dst, int lane) {
    const f32x4 v = ((const GAS f32x4*)src)[lane];
    ((GAS unsigned long long*)dst)[lane] = (unsigned long long)pk2(v.x, v.y) | ((unsigned long long)pk2(v.z, v.w) << 32);
}

template <int KIND>
__device__ __forceinline__ void conv_group(const bf16* Ub, const float* state, float* cs_out, const LAS float* wl, const float* bdw, const float* lng, const float* lnb,
                                           bf16* Y2, int seq, int t0, int lane) {
    const int ch = 8 * lane;
    float acc[4][8];
    { const f32x4 b0 = *(const GAS f32x4*)(bdw + ch), b1 = *(const GAS f32x4*)(bdw + ch + 4);
#pragma unroll
      for (int o = 0; o < 4; ++o) { acc[o][0] = b0.x; acc[o][1] = b0.y; acc[o][2] = b0.z; acc[o][3] = b0.w; acc[o][4] = b1.x; acc[o][5] = b1.y; acc[o][6] = b1.z; acc[o][7] = b1.w; } }
    const size_t urow0 = (KIND == 0) ? (size_t)seq * SEQ : (size_t)MP + (size_t)seq * DS;
#pragma unroll
    for (int i = 0; i < 34; ++i) {
        float u[8];
        bool nz = true;
        if (KIND == 0) {
            const int t = t0 + i - 30;
            if (t >= 0) { const v4u w = *(const GAS v4u*)(Ub + (urow0 + t) * DC + ch);
                u[0] = bf_lo(w.x); u[1] = bf_hi(w.x); u[2] = bf_lo(w.y); u[3] = bf_hi(w.y); u[4] = bf_lo(w.z); u[5] = bf_hi(w.z); u[6] = bf_lo(w.w); u[7] = bf_hi(w.w); }
            else { nz = false;
#pragma unroll
                for (int k = 0; k < 8; ++k) u[k] = 0.f; }
        } else {
            if (i < 30) { const float* sp = state + ((size_t)seq * 30 + i) * DC + ch; const f32x4 a = *(const GAS f32x4*)sp, b = *(const GAS f32x4*)(sp + 4);
                u[0] = a.x; u[1] = a.y; u[2] = a.z; u[3] = a.w; u[4] = b.x; u[5] = b.y; u[6] = b.z; u[7] = b.w;
                if (i >= 4) { float* cp = cs_out + ((size_t)seq * 30 + (i - 4)) * DC + ch; *(GAS f32x4*)cp = a; *(GAS f32x4*)(cp + 4) = b; } }
            else { const v4u w = *(const GAS v4u*)(Ub + (urow0 + (i - 30)) * DC + ch);
                u[0] = bf_lo(w.x); u[1] = bf_hi(w.x); u[2] = bf_lo(w.y); u[3] = bf_hi(w.y); u[4] = bf_lo(w.z); u[5] = bf_hi(w.z); u[6] = bf_lo(w.w); u[7] = bf_hi(w.w); }
        }
        if (nz) {
#pragma unroll
            for (int o = 0; o < 4; ++o) {
                const int j = i - o;
                if (j >= 0 && j <= 30) {
                    const f32x4 w0 = *(const LAS f32x4*)(wl + j * DC + ch), w1 = *(const LAS f32x4*)(wl + j * DC + ch + 4);
                    acc[o][0] = fmaf(w0.x, u[0], acc[o][0]); acc[o][1] = fmaf(w0.y, u[1], acc[o][1]); acc[o][2] = fmaf(w0.z, u[2], acc[o][2]); acc[o][3] = fmaf(w0.w, u[3], acc[o][3]);
                    acc[o][4] = fmaf(w1.x, u[4], acc[o][4]); acc[o][5] = fmaf(w1.y, u[5], acc[o][5]); acc[o][6] = fmaf(w1.z, u[6], acc[o][6]); acc[o][7] = fmaf(w1.w, u[7], acc[o][7]);
                }
            }
        }
    }
    const f32x4 g0 = *(const GAS f32x4*)(lng + ch), g1 = *(const GAS f32x4*)(lng + ch + 4), c0 = *(const GAS f32x4*)(lnb + ch), c1 = *(const GAS f32x4*)(lnb + ch + 4);
    const float gg[8] = {g0.x, g0.y, g0.z, g0.w, g1.x, g1.y, g1.z, g1.w}, cc[8] = {c0.x, c0.y, c0.z, c0.w, c1.x, c1.y, c1.z, c1.w};
#pragma unroll
    for (int o = 0; o < 4; ++o) {
        float s = 0.f;
#pragma unroll
        for (int k = 0; k < 8; ++k) s += acc[o][k];
        const float mean = wave_sum(s) * (1.f / DC);
        float q = 0.f;
#pragma unroll
        for (int k = 0; k < 8; ++k) { const float d = acc[o][k] - mean; q = fmaf(d, d, q); }
        const float rstd = 1.f / sqrtf(wave_sum(q) * (1.f / DC) + EPS);
        float y[8];
#pragma unroll
        for (int k = 0; k < 8; ++k) { const float z = (acc[o][k] - mean) * rstd * gg[k] + cc[k]; y[k] = z * sigmoidf_fast(z); }
        v4u w; w.x = pk2(y[0], y[1]); w.y = pk2(y[2], y[3]); w.z = pk2(y[4], y[5]); w.w = pk2(y[6], y[7]);
        const size_t row = (KIND == 0) ? urow0 + t0 + o : urow0 + o;
        *(GAS v4u*)(Y2 + row * DM + DA + ch) = w;
    }
}


namespace att {
using bf16x8 = __attribute__((ext_vector_type(8))) short;
using s16x4  = __attribute__((ext_vector_type(4))) short;
using f32x16 = __attribute__((ext_vector_type(16))) float;
using u32x4  = __attribute__((ext_vector_type(4))) unsigned;
constexpr int KVBLK = 64, LD = 512;
constexpr int SHM_V = 64 * 128 * 2, SHM_K = 64 * 128 * 2;
constexpr int LDS_V = 0, LDS_K = 2 * SHM_V, LDS_WS = 2 * SHM_V + 2 * SHM_K, LDS_END = LDS_WS + 8 * 64 * 4;
constexpr float THR2 = 8.0f;
#define ASBAR() __builtin_amdgcn_sched_barrier(0)
__device__ __forceinline__ int crow(int r, int hi) { return (r & 3) + 8 * (r >> 2) + 4 * hi; }
__device__ __forceinline__ unsigned cvtpk(float lo, float hi) { unsigned r; asm volatile("v_cvt_pk_bf16_f32 %0, %1, %2" : "=v"(r) : "v"(lo), "v"(hi)); return r; }
__device__ __forceinline__ int k_st(int key, int ch16) { return ch16 * 1024 + ((key ^ (ch16 & 7)) << 4); }
__device__ __forceinline__ int v_st(int k, int c) { const int kk = (k & ~0xC) | ((k & 4) << 1) | ((k & 8) >> 1); return ((kk >> 3) * 4 + (c >> 5)) * 512 + ((kk & 7) * 32 + (c & 31)) * 2; }
__device__ __forceinline__ int v_rd_base(int lane) { return ((lane & 3) << 3) | (((lane >> 2) & 3) << 6) | (((lane >> 4) & 1) << 5) | (((lane >> 5) & 1) << 8); }
constexpr int v_rd_off(int d0, int ks, int half) { return d0 * 512 + ks * 4096 + half * 2048; }
template <int OFF> __device__ __forceinline__ s16x4 tr_read(int vb) { s16x4 r; asm volatile("ds_read_b64_tr_b16 %0, %1 offset:%2" : "=&v"(r) : "v"(vb), "i"(OFF) : "memory"); return r; }

__device__ __forceinline__ void partialSM(f32x16& p0, f32x16& p1, float& m_reg, float& alpha) {
  float pmax = p0[0];
#pragma unroll
  for (int r = 1; r < 16; ++r) pmax = fmaxf(pmax, p0[r]);
#pragma unroll
  for (int r = 0; r < 16; ++r) pmax = fmaxf(pmax, p1[r]);
  { auto rr = __builtin_amdgcn_permlane32_swap(__float_as_uint(pmax), __float_as_uint(pmax), false, false); pmax = fmaxf(__uint_as_float(rr[0]), __uint_as_float(rr[1])); }
  float mn;
  if (__builtin_expect(__all(pmax - m_reg <= THR2), 1)) { mn = m_reg; alpha = 1.f; }
  else { mn = fmaxf(m_reg, pmax); alpha = __builtin_amdgcn_exp2f(m_reg - mn); m_reg = mn; }
#pragma unroll
  for (int r = 0; r < 16; ++r) p0[r] = p0[r] - mn;
#pragma unroll
  for (int r = 0; r < 16; ++r) p1[r] = p1[r] - mn;
#pragma unroll
  for (int r = 0; r < 16; ++r) p0[r] = __builtin_amdgcn_exp2f(p0[r]);
}
__device__ __forceinline__ void finishSM(f32x16& p0, f32x16& p1, float alpha, float& l_reg, bf16x8& pa0, bf16x8& pa1, bf16x8& pa2, bf16x8& pa3) {
#pragma unroll
  for (int r = 0; r < 16; ++r) p1[r] = __builtin_amdgcn_exp2f(p1[r]);
  float ps = 0;
#pragma unroll
  for (int r = 0; r < 16; ++r) ps += p0[r];
#pragma unroll
  for (int r = 0; r < 16; ++r) ps += p1[r];
  { auto rr = __builtin_amdgcn_permlane32_swap(__float_as_uint(ps), __float_as_uint(ps), false, false); ps = __uint_as_float(rr[0]) + __uint_as_float(rr[1]); }
  l_reg = l_reg * alpha + ps;
#define PK4(P, BASE, OUT) do { unsigned a0 = cvtpk(P[BASE + 0], P[BASE + 1]), a1 = cvtpk(P[BASE + 2], P[BASE + 3]);   \
    unsigned b0 = cvtpk(P[BASE + 4], P[BASE + 5]), b1 = cvtpk(P[BASE + 6], P[BASE + 7]);                              \
    auto r0 = __builtin_amdgcn_permlane32_swap(a0, b0, false, false); auto r1 = __builtin_amdgcn_permlane32_swap(a1, b1, false, false); \
    u32x4 w = {r0[0], r1[0], r0[1], r1[1]}; OUT = *reinterpret_cast<bf16x8*>(&w); } while (0)
  PK4(p0, 0, pa0); PK4(p0, 8, pa1); PK4(p1, 0, pa2); PK4(p1, 8, pa3);
#undef PK4
}
__device__ __forceinline__ void qkt(f32x16& p0, f32x16& p1, const char* Ks, const bf16x8* qr, int r32, int hi, int comp, float slope2, float sb) {
#pragma unroll
  for (int r = 0; r < 16; ++r) { const float cr = (float)((r & 3) + 8 * (r >> 2)); p0[r] = fmaf(slope2, cr, sb); p1[r] = fmaf(slope2, cr + 32.f, sb); }
#pragma unroll
  for (int d0 = 0; d0 < 4; ++d0) { const int ch = comp * 8 + 2 * d0 + hi;
    const bf16x8 b0 = *reinterpret_cast<const bf16x8*>(Ks + k_st(r32, ch));
    const bf16x8 b1 = *reinterpret_cast<const bf16x8*>(Ks + k_st(32 + r32, ch));
    p0 = __builtin_amdgcn_mfma_f32_32x32x16_bf16(b0, qr[d0], p0, 0, 0, 0);
    p1 = __builtin_amdgcn_mfma_f32_32x32x16_bf16(b1, qr[d0], p1, 0, 0, 0); }
}
__device__ __forceinline__ void cmask(f32x16& p0, f32x16& p1, int krel, int qrel, int hi) {
  const int kb = krel + 4 * hi;
#pragma unroll
  for (int r = 0; r < 16; ++r) { const int kv = kb + (r & 3) + 8 * (r >> 2); if (kv > qrel) p0[r] = -INFINITY; if (kv + 32 > qrel) p1[r] = -INFINITY; }
}
template <int D0> __device__ __forceinline__ void pv_one(f32x16& od, int vb, bf16x8 pa0, bf16x8 pa1, bf16x8 pa2, bf16x8 pa3) {
  const s16x4 l0 = tr_read<v_rd_off(D0, 0, 0)>(vb), h0 = tr_read<v_rd_off(D0, 0, 1)>(vb), l1 = tr_read<v_rd_off(D0, 1, 0)>(vb), h1 = tr_read<v_rd_off(D0, 1, 1)>(vb);
  const s16x4 l2 = tr_read<v_rd_off(D0, 2, 0)>(vb), h2 = tr_read<v_rd_off(D0, 2, 1)>(vb), l3 = tr_read<v_rd_off(D0, 3, 0)>(vb), h3 = tr_read<v_rd_off(D0, 3, 1)>(vb);
  asm volatile("s_waitcnt lgkmcnt(0)" ::: "memory"); ASBAR();
#define PK(L, H) (bf16x8){L[0], L[1], L[2], L[3], H[0], H[1], H[2], H[3]}
  od = __builtin_amdgcn_mfma_f32_32x32x16_bf16(pa0, PK(l0, h0), od, 0, 0, 0);
  od = __builtin_amdgcn_mfma_f32_32x32x16_bf16(pa1, PK(l1, h1), od, 0, 0, 0);
  od = __builtin_amdgcn_mfma_f32_32x32x16_bf16(pa2, PK(l2, h2), od, 0, 0, 0);
  od = __builtin_amdgcn_mfma_f32_32x32x16_bf16(pa3, PK(l3, h3), od, 0, 0, 0);
#undef PK
}
__device__ __forceinline__ void pv_d0(f32x16* o, int vb, bf16x8 pa0, bf16x8 pa1, bf16x8 pa2, bf16x8 pa3) {
  pv_one<0>(o[0], vb, pa0, pa1, pa2, pa3); pv_one<1>(o[1], vb, pa0, pa1, pa2, pa3); pv_one<2>(o[2], vb, pa0, pa1, pa2, pa3); pv_one<3>(o[3], vb, pa0, pa1, pa2, pa3);
}

__device__ __forceinline__ void attn_unit(const unsigned short* __restrict__ Qb, const unsigned short* __restrict__ Kh, const unsigned short* __restrict__ Vh, unsigned short* __restrict__ Yb,
                                          int q0, float slope2, float lam, const float* __restrict__ gsub, char* lds) {
  int tid_ = threadIdx.x; asm volatile("" : "+v"(tid_));
  const int tid = tid_, wid = tid >> 6, lane = tid & 63, r32 = lane & 31, hi = lane >> 5, comp = wid >> 2, w4 = wid & 3;
  char* V_lds = lds + LDS_V; char* K_lds = lds + LDS_K;
  float* wsf = (float*)(lds + LDS_WS) + wid * 64; float* li_l = wsf; float* al_l = wsf + 32;
  float m_reg = -1e30f, l_reg = 0.f; f32x16 o[4] = {}; bf16x8 qr[4];
  const unsigned short* Qw = Qb + (size_t)(w4 * 32 + r32) * LD + comp * 64 + hi * 8;
#pragma unroll
  for (int d0 = 0; d0 < 4; ++d0) qr[d0] = *reinterpret_cast<const bf16x8*>(Qw + d0 * 16);
  const int sr = tid >> 4, sc = (tid & 15) * 8;
  const int vst0 = v_st(sr, sc), vst1 = v_st(32 + sr, sc), kst0 = k_st(sr, tid & 15), kst1 = k_st(32 + sr, tid & 15);
  const int vb0 = (int)(uintptr_t)V_lds + v_rd_base(lane);
  struct { bf16x8 vs0, vs1, ks0, ks1; } sr_[1];
#define SLOAD(i, k0) do { sr_[i].vs0 = *reinterpret_cast<const bf16x8*>(&Vh[(size_t)((k0) + sr) * LD + sc]); sr_[i].vs1 = *reinterpret_cast<const bf16x8*>(&Vh[(size_t)((k0) + 32 + sr) * LD + sc]); \
    sr_[i].ks0 = *reinterpret_cast<const bf16x8*>(&Kh[(size_t)((k0) + sr) * LD + sc]); sr_[i].ks1 = *reinterpret_cast<const bf16x8*>(&Kh[(size_t)((k0) + 32 + sr) * LD + sc]); } while (0)
#define SWRITE(b, i) do { *(bf16x8*)(V_lds + (b) * SHM_V + vst0) = sr_[i].vs0; *(bf16x8*)(V_lds + (b) * SHM_V + vst1) = sr_[i].vs1; \
    *(bf16x8*)(K_lds + (b) * SHM_K + kst0) = sr_[i].ks0; *(bf16x8*)(K_lds + (b) * SHM_K + kst1) = sr_[i].ks1; } while (0)
#define SWAIT() asm volatile("s_waitcnt vmcnt(0)" ::: "memory")
#define RESC(a) do { if (__any((a) < 1.f)) { if (hi == 0) al_l[r32] = (a); asm volatile("s_waitcnt lgkmcnt(0)" ::: "memory"); \
    _Pragma("unroll") for (int d = 0; d < 4; ++d) _Pragma("unroll") for (int r = 0; r < 16; ++r) o[d][r] *= al_l[crow(r, hi)]; } } while (0)
  const int NT = (q0 + 128) / KVBLK;
  const int qrel = w4 * 32 + r32, qpos = q0 + qrel;
#define SB(t) (slope2 * (float)(64 * (t) + 4 * hi - qpos))
#define MASK(P0, P1, t) do { if ((t) >= NT - 2) cmask(P0, P1, 64 * (t) - q0, qrel, hi); } while (0)
  f32x16 pA0, pA1, pB0, pB1; float alA, alB; bf16x8 pa0, pa1, pa2, pa3;
  SLOAD(0, 0); asm volatile("s_waitcnt vmcnt(0)" ::: "memory"); SWRITE(0, 0); __syncthreads();
  qkt(pA0, pA1, K_lds, qr, r32, hi, comp, slope2, SB(0)); MASK(pA0, pA1, 0); partialSM(pA0, pA1, m_reg, alA);
  SLOAD(0, KVBLK);
  SWAIT(); SWRITE(1, 0); __syncthreads();
  for (int j = 1; j + 1 < NT; j += 2) {
    ASBAR(); qkt(pB0, pB1, K_lds + SHM_K, qr, r32, hi, comp, slope2, SB(j)); MASK(pB0, pB1, j);
    finishSM(pA0, pA1, alA, l_reg, pa0, pa1, pa2, pa3); ASBAR();
    SLOAD(0, (j + 1) * KVBLK); ASBAR();
    pv_d0(o, vb0, pa0, pa1, pa2, pa3); partialSM(pB0, pB1, m_reg, alB);
    __syncthreads(); SWAIT(); SWRITE(0, 0);
    RESC(alB); __syncthreads();
    ASBAR(); qkt(pA0, pA1, K_lds, qr, r32, hi, comp, slope2, SB(j + 1)); MASK(pA0, pA1, j + 1);
    finishSM(pB0, pB1, alB, l_reg, pa0, pa1, pa2, pa3); ASBAR();
    SLOAD(0, (j + 2) * KVBLK); ASBAR();
    pv_d0(o, vb0 + SHM_V, pa0, pa1, pa2, pa3); partialSM(pA0, pA1, m_reg, alA);
    __syncthreads(); SWAIT(); SWRITE(1, 0);
    RESC(alA); __syncthreads();
  }
  ASBAR(); qkt(pB0, pB1, K_lds + SHM_K, qr, r32, hi, comp, slope2, SB(NT - 1)); MASK(pB0, pB1, NT - 1);
  finishSM(pA0, pA1, alA, l_reg, pa0, pa1, pa2, pa3); ASBAR();
  pv_d0(o, vb0, pa0, pa1, pa2, pa3); partialSM(pB0, pB1, m_reg, alB);
  __syncthreads(); RESC(alB);
  finishSM(pB0, pB1, alB, l_reg, pa0, pa1, pa2, pa3); ASBAR();
  pv_d0(o, vb0 + SHM_V, pa0, pa1, pa2, pa3);
  int lane_e = threadIdx.x & 63; asm volatile("" : "+v"(lane_e));
  { const int r32 = lane_e & 31, hi = lane_e >> 5, lane = lane_e;
  if (hi == 0) li_l[r32] = l_reg; asm volatile("s_waitcnt lgkmcnt(0)" ::: "memory");
#pragma unroll
  for (int r = 0; r < 16; ++r) { const float rl = __builtin_amdgcn_rcpf(li_l[crow(r, hi)]);
#pragma unroll
    for (int d0 = 0; d0 < 4; ++d0) o[d0][r] *= rl; }
  __syncthreads();
  float* xch = (float*)lds + (size_t)w4 * 4096 + lane;
  if (comp == 1) {
#pragma unroll
    for (int d0 = 0; d0 < 4; ++d0)
#pragma unroll
      for (int r = 0; r < 16; ++r) xch[(d0 * 16 + r) * 64] = o[d0][r];
  }
  __syncthreads();
  if (comp == 0) {
    float ss[16];
#pragma unroll
    for (int r = 0; r < 16; ++r) ss[r] = 0.f;
#pragma unroll
    for (int d0 = 0; d0 < 4; ++d0)
#pragma unroll
      for (int r = 0; r < 16; ++r) { const float v = o[d0][r] - lam * xch[(d0 * 16 + r) * 64]; o[d0][r] = v; ss[r] = fmaf(v, v, ss[r]); }
#pragma unroll
    for (int r = 0; r < 16; ++r) {
      float s = ss[r];
      s += __shfl_xor(s, 1); s += __shfl_xor(s, 2); s += __shfl_xor(s, 4); s += __shfl_xor(s, 8); s += __shfl_xor(s, 16);
      ss[r] = (1.0f - LAM_INIT) / sqrtf(s * (1.0f / 128.0f) + EPS);
    }
    float g[4];
#pragma unroll
    for (int d0 = 0; d0 < 4; ++d0) g[d0] = gsub[d0 * 32 + r32];
    unsigned short* Yw = Yb + (size_t)(w4 * 32) * DM;
#pragma unroll
    for (int r = 0; r < 16; ++r) { const int orow = crow(r, hi);
#pragma unroll
      for (int d0 = 0; d0 < 4; ++d0) Yw[(size_t)orow * DM + d0 * 32 + r32] = (unsigned short)f2bf(o[d0][r] * ss[r] * g[d0]); }
  }
  }
  __syncthreads();
#undef SLOAD
#undef SWRITE
#undef SWAIT
#undef RESC
#undef SB
#undef MASK
}
#undef ASBAR
}


namespace dec {
template <int CTRL> __device__ __forceinline__ float dpp(float x) { return __builtin_bit_cast(float, __builtin_amdgcn_mov_dpp(__builtin_bit_cast(int, x), CTRL, 0xf, 0xf, true)); }
constexpr int XOR1 = 0xB1, XOR2 = 0x4E, XOR7 = 0x141, XOR8 = 0x128;
__device__ __forceinline__ float row16_sum(float x) { x += dpp<XOR1>(x); x += dpp<XOR2>(x); x += dpp<XOR7>(x); x += dpp<XOR8>(x); return x; }
constexpr int PPW = 4, CPP = PAGE / 16, NCH = PPW * CPP;
constexpr int MREC = 136;

__device__ __forceinline__ void decode_unit(const float* __restrict__ QS, const float* __restrict__ ck, const float* __restrict__ cv, const int* __restrict__ pt,
                                            float* __restrict__ part, int s, int h, int split, LAS float* mrg) {
    int tid_ = threadIdx.x; asm volatile("" : "+v"(tid_));
    const int tid = tid_, lane = tid & 63, wave = __builtin_amdgcn_readfirstlane(tid >> 6), kk = lane >> 5, dl = lane & 31, comp = dl >> 4;
    const float slope2 = alibi_slope2(h);
    f32x4 Qr[DS];
#pragma unroll
    for (int q = 0; q < DS; ++q) Qr[q] = *(const GAS f32x4*)(QS + (size_t)(s * DS + q) * DA + h * 128 + dl * 4);
    float m[DS], l[DS]; f32x4 aown[DS], aoth[DS];
#pragma unroll
    for (int q = 0; q < DS; ++q) { m[q] = -1e30f; l[q] = 0.f; aown[q] = (f32x4){0.f, 0.f, 0.f, 0.f}; aoth[q] = (f32x4){0.f, 0.f, 0.f, 0.f}; }
    const int page0 = split * (NPAGES / DSPLIT) + wave * PPW;
    const size_t loff = (size_t)kk * DA + h * 128 + dl * 4;
    f32x4 Kn[8], Vn[8];
#define DISSUE(ci_) do { const int pg_ = page0 + ((ci_) >> 3); const int phys_ = __builtin_amdgcn_readfirstlane(pt[s * NPAGES + pg_]); \
        const size_t base_ = ((size_t)phys_ * PAGE + (size_t)((ci_) & 7) * 16) * DA + loff; \
        _Pragma("unroll") for (int i_ = 0; i_ < 8; ++i_) { Kn[i_] = __builtin_nontemporal_load((const GAS f32x4*)(ck + base_ + (size_t)i_ * 2 * DA)); \
                                                          Vn[i_] = __builtin_nontemporal_load((const GAS f32x4*)(cv + base_ + (size_t)i_ * 2 * DA)); } } while (0)
    DISSUE(0);
    for (int ci = 0; ci < NCH; ++ci) {
        f32x4 Kc[8], Vc[8];
#pragma unroll
        for (int i = 0; i < 8; ++i) { Kc[i] = Kn[i]; Vc[i] = Vn[i]; }
        if (ci + 1 < NCH) DISSUE(ci + 1);
        const int kpos0 = (page0 + (ci >> 3)) * PAGE + (ci & 7) * 16 + kk;
        float sc[8][DS];
#pragma unroll
        for (int i = 0; i < 8; ++i)
#pragma unroll
            for (int q = 0; q < DS; ++q) {
                float d = Kc[i].x * Qr[q].x; d = fmaf(Kc[i].y, Qr[q].y, d); d = fmaf(Kc[i].z, Qr[q].z, d); d = fmaf(Kc[i].w, Qr[q].w, d);
                d = row16_sum(d);
                sc[i][q] = fmaf(slope2, (float)(kpos0 + 2 * i - (PAST + q)), d);
            }
        float al[DS];
#pragma unroll
        for (int q = 0; q < DS; ++q) {
            float cm = sc[0][q];
#pragma unroll
            for (int i = 1; i < 8; ++i) cm = fmaxf(cm, sc[i][q]);
            cm = fmaxf(cm, __shfl_xor(cm, 32));
            const float mn = fmaxf(m[q], cm);
            al[q] = __builtin_amdgcn_exp2f(m[q] - mn); m[q] = mn;
            float ls = 0.f;
#pragma unroll
            for (int i = 0; i < 8; ++i) { sc[i][q] = __builtin_amdgcn_exp2f(sc[i][q] - mn); ls += sc[i][q]; }
            l[q] = fmaf(l[q], al[q], ls);
        }
#pragma unroll
        for (int q = 0; q < DS; ++q) { const float ao = __shfl_xor(al[q], 16); aown[q] = aown[q] * al[q]; aoth[q] = aoth[q] * ao; }
#pragma unroll
        for (int i = 0; i < 8; ++i)
#pragma unroll
            for (int q = 0; q < DS; ++q) { const float p = sc[i][q], po = __shfl_xor(p, 16);
                aown[q].x = fmaf(p, Vc[i].x, aown[q].x); aown[q].y = fmaf(p, Vc[i].y, aown[q].y); aown[q].z = fmaf(p, Vc[i].z, aown[q].z); aown[q].w = fmaf(p, Vc[i].w, aown[q].w);
                aoth[q].x = fmaf(po, Vc[i].x, aoth[q].x); aoth[q].y = fmaf(po, Vc[i].y, aoth[q].y); aoth[q].z = fmaf(po, Vc[i].z, aoth[q].z); aoth[q].w = fmaf(po, Vc[i].w, aoth[q].w); }
    }
#undef DISSUE
#pragma unroll
    for (int q = 0; q < DS; ++q) {
        l[q] += __shfl_xor(l[q], 32);
        aown[q].x += __shfl_xor(aown[q].x, 32); aown[q].y += __shfl_xor(aown[q].y, 32); aown[q].z += __shfl_xor(aown[q].z, 32); aown[q].w += __shfl_xor(aown[q].w, 32);
        aoth[q].x += __shfl_xor(aoth[q].x, 32); aoth[q].y += __shfl_xor(aoth[q].y, 32); aoth[q].z += __shfl_xor(aoth[q].z, 32); aoth[q].w += __shfl_xor(aoth[q].w, 32);
    }
    if (kk == 0) {
#pragma unroll
        for (int q = 0; q < DS; ++q) {
            LAS float* ro = mrg + (size_t)((wave * 2 + comp) * DS + q) * MREC; LAS float* rx = mrg + (size_t)((wave * 2 + (comp ^ 1)) * DS + q) * MREC;
            *(LAS f32x4*)(ro + 8 + dl * 4) = aown[q]; *(LAS f32x4*)(rx + 8 + dl * 4) = aoth[q];
            if ((dl & 15) == 0) { ro[0] = m[q]; ro[1] = l[q]; }
        }
    }
    __syncthreads();
    {
        const int e = tid & 127;
#pragma unroll
        for (int t = 0; t < 2; ++t) {
            const int cq = (tid >> 7) + 4 * t;
            float M = -1e30f;
#pragma unroll
            for (int w = 0; w < NWAVES; ++w) M = fmaxf(M, mrg[(size_t)(w * 8 + cq) * MREC]);
            float L = 0.f, O = 0.f;
#pragma unroll
            for (int w = 0; w < NWAVES; ++w) { const LAS float* r = mrg + (size_t)(w * 8 + cq) * MREC; const float wt = __builtin_amdgcn_exp2f(r[0] - M); L = fmaf(wt, r[1], L); O = fmaf(wt, r[8 + e], O); }
            float* pr = part + ((size_t)((s * NH + h) * DSPLIT + split) * 8 + cq) * PREC;
            pr[4 + e] = O; if (e == 0) { pr[0] = M; pr[1] = L; }
        }
    }
    __syncthreads();
}

__device__ __forceinline__ void decode_finish(const float* __restrict__ QS, const float* __restrict__ KS, const float* __restrict__ VS, const float* __restrict__ part,
                                              const float* __restrict__ gsub, float lam, bf16* __restrict__ Y2, int s, int h, int q, int lane) {
    const float slope2 = alibi_slope2(h);
    float oc[2][2];
#pragma unroll
    for (int c = 0; c < 2; ++c) {
        float sn[DS];
        const float qv = QS[(size_t)(s * DS + q) * DA + h * 128 + c * 64 + lane];
#pragma unroll
        for (int j = 0; j < DS; ++j) { const float d = wave_sum(qv * KS[(size_t)(s * DS + j) * DA + h * 128 + c * 64 + lane]); sn[j] = (j <= q) ? fmaf(slope2, (float)(j - q), d) : -INFINITY; }
        float M = sn[0];
#pragma unroll
        for (int j = 1; j < DS; ++j) M = fmaxf(M, sn[j]);
        const float* pr[DSPLIT];
#pragma unroll
        for (int sp = 0; sp < DSPLIT; ++sp) { pr[sp] = part + ((size_t)((s * NH + h) * DSPLIT + sp) * 8 + c * DS + q) * PREC; M = fmaxf(M, pr[sp][0]); }
        float L = 0.f, o0 = 0.f, o1 = 0.f;
#pragma unroll
        for (int sp = 0; sp < DSPLIT; ++sp) { const float wt = __builtin_amdgcn_exp2f(pr[sp][0] - M); L = fmaf(wt, pr[sp][1], L); o0 = fmaf(wt, pr[sp][4 + 2 * lane], o0); o1 = fmaf(wt, pr[sp][4 + 2 * lane + 1], o1); }
#pragma unroll
        for (int j = 0; j < DS; ++j) { const float p = __builtin_amdgcn_exp2f(sn[j] - M); const float* vr = VS + (size_t)(s * DS + j) * DA + h * 128 + 2 * lane;
            L += p; o0 = fmaf(p, vr[0], o0); o1 = fmaf(p, vr[1], o1); }
        const float inv = 1.f / L;
        oc[c][0] = o0 * inv; oc[c][1] = o1 * inv;
    }
    const float a0 = oc[0][0] - lam * oc[1][0], a1 = oc[0][1] - lam * oc[1][1];
    const float r = (1.0f - LAM_INIT) / sqrtf(wave_sum(a0 * a0 + a1 * a1) * (1.f / 128.f) + EPS);
    *(GAS unsigned*)(Y2 + (size_t)(MP + s * DS + q) * DM + h * 128 + 2 * lane) = pk2(a0 * r * gsub[2 * lane], a1 * r * gsub[2 * lane + 1]);
}
}


struct Args { const float* in[27]; float* out; unsigned char* ws; int k_dm, k_ff, k_ple, pad; };
template <int LO, int HI>
__global__ void __launch_bounds__(NWAVES * 64, 2) mk_fwd(Args args) {
    extern __shared__ __attribute__((aligned(16))) unsigned char lds[];
    Frame F;
    F.lds = (LAS unsigned char*)lds;
    F.MISC = (volatile LAS unsigned*)(F.lds + MISC_OFF);
    F.tid = threadIdx.x; F.lane = F.tid & 63; F.wave = __builtin_amdgcn_readfirstlane(F.tid >> 6);
    F.G = gridDim.x; { const int bx = blockIdx.x; F.vcu = (F.G % 8 == 0) ? (bx % 8) * (F.G / 8) + bx / 8 : bx; }
    unsigned char* ws = args.ws;
    F.ctl = (gu32*)(ws + WS_CTL);
    const float* x_p = args.in[0]; const float* x_s = args.in[1]; const float* cache_k = args.in[2]; const float* cache_v = args.in[3]; const float* state_conv = args.in[4];
    const int* page_table = (const int*)args.in[5]; const float* p_p = args.in[6]; const float* p_s = args.in[7];
    const float* w_in = args.in[8]; const float* w_out = args.in[9];
    const float* lq1 = args.in[10]; const float* lk1 = args.in[11]; const float* lq2 = args.in[12]; const float* lk2 = args.in[13];
    const float* g_subln = args.in[14]; const float* w_dw = args.in[15]; const float* b_dw = args.in[16]; const float* ln_g = args.in[17]; const float* ln_b = args.in[18];
    const float* g_pre_mix = args.in[19]; const float* g_post_mix = args.in[20]; const float* g_pre_ffn = args.in[21]; const float* g_post_ffn = args.in[22];
    const float* w_ff1 = args.in[23]; const float* w_ff2 = args.in[24]; const float* w_ple = args.in[25]; const float* w_gate = args.in[26];
    float* out = args.out;
    bf16* Win_t = (bf16*)(ws + WS_WIN); bf16* Wout_t = (bf16*)(ws + WS_WOUT); bf16* Wff1_t = (bf16*)(ws + WS_WFF1); bf16* Wff2_t = (bf16*)(ws + WS_WFF2);
    bf16* Wgate_t = (bf16*)(ws + WS_WGATE); bf16* Wple_t = (bf16*)(ws + WS_WPLE);
    bf16* XN = (bf16*)(ws + WS_XN); bf16* Qb = (bf16*)(ws + WS_Q); bf16* Kb = (bf16*)(ws + WS_K); bf16* Vb = (bf16*)(ws + WS_V); bf16* Ub = (bf16*)(ws + WS_U);
    bf16* Y2 = (bf16*)(ws + WS_Y2); float* MM = (float*)(ws + WS_MM); float* Hf = (float*)(ws + WS_H); bf16* HN = (bf16*)(ws + WS_HN); bf16* HH = (bf16*)(ws + WS_HH);
    float* FFo = (float*)(ws + WS_FF); float* H2 = (float*)(ws + WS_H2); bf16* H2B = (bf16*)(ws + WS_H2B); bf16* PEb = (bf16*)(ws + WS_PE); bf16* Eb = (bf16*)(ws + WS_E);
    float* QS = (float*)(ws + WS_QS); float* DP = (float*)(ws + WS_DP);


#define IN(k) (LO <= (k) && (k) < HI)
#define SEAM(k) do { if constexpr (IN(k) && IN((k) + 1)) xcd_barrier(bar); } while (0)
    for (int u = F.tid; u < (LDS_BYTES - LDSCTL_OFF) / 4; u += NWAVES * 64) ((LAS unsigned*)(F.lds + LDSCTL_OFF))[u] = 0u;
    __syncthreads();
    XcdBarrier bar; bar.bar = (unsigned*)(F.ctl + CW_BAR); bar.x = 0; bar.st = nullptr;
    if constexpr (HI - LO > 1) bar = xcd_barrier_post((unsigned*)(F.ctl + CW_BAR), F.MISC + 8);
    const int gw = F.vcu * NWAVES + F.wave, NGW = F.G * NWAVES;

    if constexpr (IN(0)) {
        LAS float* scr = (LAS float*)(F.lds + RING_OFF + F.wave * 16384);
        constexpr int I_IN = (DM / 64) * (NIN / 32), I_OUT = (DM / 64) * (DM / 32), I_F1 = (DM / 64) * (DFF / 32), I_F2 = (DFF / 64) * (DM / 32), I_G = I_OUT, I_P = (DPLE / 64) * (DM / 32);
        constexpr int NITEMS = I_IN + I_OUT + I_F1 + I_F2 + I_G + I_P;
        for (int it = gw; it < NITEMS; it += NGW) {
            int r = it;
            if (r < I_IN) { const int nblk = NIN / 32, kb = r / nblk, nb = r % nblk; p0_transpose_item(w_in, DM, NIN, Win_t, 64 * kb, 32 * nb, win_dest_row(32 * nb), scr, F.lane); continue; } r -= I_IN;
            if (r < I_OUT) { const int nblk = DM / 32, kb = r / nblk, nb = r % nblk; p0_transpose_item(w_out, DM, DM, Wout_t, 64 * kb, 32 * nb, 32 * nb, scr, F.lane); continue; } r -= I_OUT;
            if (r < I_F1) { const int nblk = DFF / 32, kb = r / nblk, nb = r % nblk; p0_transpose_item(w_ff1, DM, DFF, Wff1_t, 64 * kb, 32 * nb, 32 * nb, scr, F.lane); continue; } r -= I_F1;
            if (r < I_F2) { const int nblk = DM / 32, kb = r / nblk, nb = r % nblk; p0_transpose_item(w_ff2, DFF, DM, Wff2_t, 64 * kb, 32 * nb, 32 * nb, scr, F.lane); continue; } r -= I_F2;
            if (r < I_G) { const int nblk = DM / 32, kb = r / nblk, nb = r % nblk; p0_transpose_item(w_gate, DM, DM, Wgate_t, 64 * kb, 32 * nb, 32 * nb, scr, F.lane); continue; } r -= I_G;
            { const int nblk = DM / 32, kb = r / nblk, nb = r % nblk; p0_transpose_item(w_ple, DPLE, DM, Wple_t, 64 * kb, 32 * nb, 32 * nb, scr, F.lane); }
        }
        for (int m = gw; m < MR; m += NGW) {
            rms_row_to_bf16(x_row(x_p, x_s, m), g_pre_mix, XN + (size_t)m * DM, F.lane);
            cvt_row256(m < MP ? p_p + (size_t)m * DPLE : p_s + (size_t)(m - MP) * DPLE, PEb + (size_t)m * DPLE, F.lane);
        }
        for (int m = MR + gw; m < MT; m += NGW) {
            ((GAS unsigned long long*)(XN + (size_t)m * DM))[F.lane] = 0ull; ((GAS unsigned long long*)(XN + (size_t)m * DM))[64 + F.lane] = 0ull;
            ((GAS unsigned long long*)(XN + (size_t)m * DM))[128 + F.lane] = 0ull; ((GAS unsigned long long*)(XN + (size_t)m * DM))[192 + F.lane] = 0ull;
            ((GAS unsigned long long*)(PEb + (size_t)m * DPLE))[F.lane] = 0ull;
        }
    }
    SEAM(0);

    if constexpr (IN(1)) {
        {
            pg8::Gemm g{XN, Win_t, MT, NIN, args.k_dm}; pg8::StaticOrder S; S.init(MT, NIN, F.G, (int)blockIdx.x);
            EpiIn E{Qb, Kb, Vb, Ub, QS, out};
            pg8::gemm_phase<EpiIn, pg8::StaticOrder, true, true>(F.lds + RING_OFF, g, S, E);
        }
        {
            pg8::Gemm g{PEb, Wple_t, MT, DM, args.k_ple}; pg8::StaticOrder S; S.init(MT, DM, F.G, (int)blockIdx.x);
            EpiB16<0> E{Eb, DM};
            pg8::gemm_phase<EpiB16<0>, pg8::StaticOrder, true, true>(F.lds + RING_OFF, g, S, E);
        }
    }
    SEAM(1);

    if constexpr (IN(2)) {
        const float lam = __builtin_bit_cast(float, __builtin_amdgcn_readfirstlane(__builtin_bit_cast(int, diff_lambda(lq1, lk1, lq2, lk2, F.lane))));
        for (int uu = F.vcu; uu < 512; uu += F.G) {
            const int v = uu & 255, second = uu >> 8;
            const int bh = v >> 3, sidx = v & 7, qb = second ? 15 - sidx : sidx;
            const int b = bh >> 2, h = bh & 3;
            const size_t row0 = (size_t)b * SEQ + (size_t)qb * 128;
            att::attn_unit(Qb + row0 * DA + h * 128, Kb + (size_t)b * SEQ * DA + h * 128, Vb + (size_t)b * SEQ * DA + h * 128,
                           Y2 + row0 * DM + h * 128, qb * 128, alibi_slope2(h), lam, g_subln, (char*)lds + RING_OFF);
        }
    }
    if constexpr (IN(3)) {
        LAS float* wl = (LAS float*)(F.lds + RING_OFF);
        for (int i = F.tid; i < CW * DC / 4; i += NWAVES * 64) ((LAS f32x4*)wl)[i] = ((const GAS f32x4*)w_dw)[i];
        __syncthreads();
        for (int cu = F.vcu; cu < 256 + 4; cu += F.G) {
            if (cu < 256) { const int b = cu >> 5, blk = cu & 31;
                for (int gi = 0; gi < 2; ++gi) conv_group<0>(Ub, nullptr, nullptr, wl, b_dw, ln_g, ln_b, Y2, b, blk * 64 + F.wave * 8 + gi * 4, F.lane); }
            else { const int s = (cu - 256) * 8 + F.wave; conv_group<1>(Ub, state_conv, out + O_CS, wl, b_dw, ln_g, ln_b, Y2, s, 0, F.lane); }
        }
        __syncthreads();
    }
    if constexpr (IN(4)) {
        for (int du = F.vcu; du < DB * NH * DSPLIT; du += F.G) {
            const int s = du >> 3, h = (du >> 1) & 3, sp = du & 1;
            dec::decode_unit(QS, cache_k, cache_v, page_table, DP, s, h, sp, (LAS float*)(F.lds + RING_OFF));
        }
    }
    SEAM(4);

    if constexpr (IN(5)) {
        const float lam = diff_lambda(lq1, lk1, lq2, lk2, F.lane);
        for (int t = gw; t < DB * NH * DS; t += NGW) { const int s = t >> 4, h = (t >> 2) & 3, q = t & 3;
            dec::decode_finish(QS, out + O_KS, out + O_VS, DP, g_subln, lam, Y2, s, h, q, F.lane); }
    }
    SEAM(5);

    if constexpr (IN(6)) {
        pg8::Gemm g{Y2, Wout_t, MT, DM, args.k_dm}; pg8::StaticOrder S; S.init(MT, DM, F.G, (int)blockIdx.x);
        EpiF32 E{MM, DM};
        pg8::gemm_phase<EpiF32, pg8::StaticOrder, true, true>(F.lds + RING_OFF, g, S, E);
    }
    SEAM(6);
    if constexpr (IN(7)) {
        for (int m = gw; m < MR; m += NGW) post_mix_row(MM + (size_t)m * DM, x_row(x_p, x_s, m), g_post_mix, g_pre_ffn, Hf + (size_t)m * DM, HN + (size_t)m * DM, F.lane);
    }
    SEAM(7);
    if constexpr (IN(8)) {
        pg8::Gemm g{HN, Wff1_t, MT, DFF, args.k_dm}; pg8::StaticOrder S; S.init(MT, DFF, F.G, (int)blockIdx.x);
        EpiB16<1> E{HH, DFF};
        pg8::gemm_phase<EpiB16<1>, pg8::StaticOrder, true, true>(F.lds + RING_OFF, g, S, E);
    }
    SEAM(8);
    if constexpr (IN(9)) {
        pg8::Gemm g{HH, Wff2_t, MT, DM, args.k_ff}; pg8::StaticOrder S; S.init(MT, DM, F.G, (int)blockIdx.x);
        EpiF32 E{FFo, DM};
        pg8::gemm_phase<EpiF32, pg8::StaticOrder, true, true>(F.lds + RING_OFF, g, S, E);
    }
    SEAM(9);
    if constexpr (IN(10)) {
        for (int m = gw; m < MR; m += NGW) post_ffn_row(FFo + (size_t)m * DM, Hf + (size_t)m * DM, g_post_ffn, H2 + (size_t)m * DM, H2B + (size_t)m * DM, F.lane);
    }
    SEAM(10);
    if constexpr (IN(11)) {
        pg8::Gemm g{H2B, Wgate_t, MT, DM, args.k_dm}; pg8::StaticOrder S; S.init(MT, DM, F.G, (int)blockIdx.x);
        EpiGate E{H2, Eb, out};
        pg8::gemm_phase<EpiGate, pg8::StaticOrder, true, true>(F.lds + RING_OFF, g, S, E);
    }
#undef IN
#undef SEAM
}

#ifndef MK_N_LAUNCHES
#define MK_N_LAUNCHES 12
#endif
constexpr int NPH = 12;
template <int LO, int HI> static bool launch_range(int grid, const Args& a, hipStream_t stream) {
    static bool attr_set = false;
    if (!attr_set) { if (hipFuncSetAttribute((const void*)mk_fwd<LO, HI>, hipFuncAttributeMaxDynamicSharedMemorySize, LDS_BYTES) != hipSuccess) { fprintf(stderr, "kernel_launch: hipFuncSetAttribute failed\n"); return false; } attr_set = true; }
    hipLaunchKernelGGL((mk_fwd<LO, HI>), dim3(grid), dim3(NWAVES * 64), LDS_BYTES, stream, a);
    const hipError_t le = hipPeekAtLastError();
    if (le != hipSuccess) { fprintf(stderr, "kernel_launch: launch [%d,%d) failed: %s\n", LO, HI, hipGetErrorName(le)); return false; }
    return true;
}
extern "C" void kernel_launch(void* const* d_in, const int* in_sizes, int n_in, void* d_out, int out_size, void* d_ws, size_t ws_size, hipStream_t stream) {
    static int grid = 0;
    if (grid == 0) {
        if (n_in != 27 || in_sizes[0] != MP * DM || out_size != (int)O_END || ws_size < WS_END) {
            fprintf(stderr, "kernel_launch: unexpected problem shape: n_in %d in0 %d out %d ws %zu (need %zu)\n", n_in, n_in > 0 ? in_sizes[0] : -1, out_size, ws_size, (size_t)WS_END); grid = -1; return; }
        int dev = 0, cus = 0;
        if (hipGetDevice(&dev) != hipSuccess || hipDeviceGetAttribute(&cus, hipDeviceAttributeMultiprocessorCount, dev) != hipSuccess) { fprintf(stderr, "kernel_launch: device query failed\n"); grid = -1; return; }
        grid = cus;
    }
    if (grid < 0) return;
    if (hipMemsetAsync((char*)d_ws + WS_CTL, 0, CTL_ZERO_BYTES, stream) != hipSuccess) { fprintf(stderr, "kernel_launch: memset failed\n"); return; }
    Args a{};
    for (int i = 0; i < 27; ++i) a.in[i] = (const float*)d_in[i];
    a.out = (float*)d_out; a.ws = (unsigned char*)d_ws; a.k_dm = DM; a.k_ff = DFF; a.k_ple = DPLE; a.pad = 0;
#if MK_N_LAUNCHES == 1
    launch_range<0, 12>(grid, a, stream);
#else
    launch_range<0, 1>(grid, a, stream) && launch_range<1, 2>(grid, a, stream) && launch_range<2, 3>(grid, a, stream) && launch_range<3, 4>(grid, a, stream) &&
    launch_range<4, 5>(grid, a, stream) && launch_range<5, 6>(grid, a, stream) && launch_range<6, 7>(grid, a, stream) && launch_range<7, 8>(grid, a, stream) &&
    launch_range<8, 9>(grid, a, stream) && launch_range<9, 10>(grid, a, stream) && launch_range<10, 11>(grid, a, stream) && launch_range<11, 12>(grid, a, stream);
#endif
}
```

```cpp
#include <hip/hip_runtime.h>
#include <cstdio>
#include <cstdint>
#include <cmath>

namespace pg8 {
#define PG8_LAS __attribute__((address_space(3)))
typedef unsigned short bf16_t;
typedef short bf16x8 __attribute__((ext_vector_type(8)));
typedef float f32x4 __attribute__((ext_vector_type(4)));
typedef unsigned u32x4 __attribute__((ext_vector_type(4)));
constexpr int BM = 256, BK = 64, HALF = 128, HTB = HALF * BK * 2  , STAGE_BYTES = 8 * HTB, NXCD = 8, WGM = 8;

__host__ __device__ __forceinline__ int lds_byte(int r, int c) { const int st = (r >> 4) * 2 + (c >> 5), rr = r & 15, cc = c & 31, ob = rr * 64 + cc * 2; return st * 1024 + (ob ^ (((ob >> 9) & 1) << 5)); }
__host__ __device__ __forceinline__ void stage_rc(int b, int& R, int& C) { const int st = b / 1024, sb = b % 1024, swz = sb ^ (((sb >> 9) & 1) << 5); R = (st >> 1) * 16 + swz / 64; C = (st & 1) * 32 + (swz % 64) / 2; }
__host__ __device__ __forceinline__ int perm32(int rho) { const int n = rho >> 4, i = rho & 15; return 8 * (i >> 2) + 4 * n + (i & 3); }

struct Unit { int pm, pn; };
struct Gemm { const bf16_t* A; const bf16_t* Bt; int M, N, K; };

struct StaticOrder {
    int nM, nN, nwg, G, c;
    __host__ __device__ void init(int M, int N, int G_, int c_) { nM = M / BM; nN = N / BM; nwg = nM * nN; G = G_; c = c_; }
    __host__ __device__ bool next(int i, Unit& u) const {
        const long L = (long)i * G + c; if (L >= nwg) return false;
        int wgid = (int)L; { const int q = nwg / NXCD, r = nwg % NXCD, xcd = wgid % NXCD, off = wgid / NXCD; wgid = (xcd < r ? xcd * (q + 1) : r * (q + 1) + (xcd - r) * q) + off; }
        const int nig = WGM * nN, gid = wgid / nig, fm = gid * WGM, gsz = (nM - fm) < WGM ? (nM - fm) : WGM;
        u.pm = fm + ((wgid % nig) % gsz); u.pn = (wgid % nig) / gsz; return true;
    }
    __device__ __forceinline__ void a_ready(const Unit&) const {}
    __device__ __forceinline__ void done(const Unit&) const {}
};


__device__ __forceinline__ unsigned cvt_pk_bf16(float lo, float hi) { unsigned r; asm volatile("v_cvt_pk_bf16_f32 %0, %1, %2" : "=v"(r) : "v"(lo), "v"(hi)); return r; }
typedef float f32x2 __attribute__((ext_vector_type(2)));

template <class Epi, class Sched, bool ALIGN_EPI = false, bool SP2 = false>
__device__ __forceinline__ void gemm_phase(PG8_LAS unsigned char* lds, const Gemm g, const Sched& S, const Epi& E, int tid_in) {
    int tid_ = tid_in; asm volatile("" : "+v"(tid_));
    const int tid = tid_, wid = __builtin_amdgcn_readfirstlane(tid >> 6), lane = tid & 63, wr = wid >> 2, wc = wid & 3, fr = lane & 15, fq = lane >> 4;
    const int K = g.K, nt = K / BK;
    unsigned voffA[2], voffB[2];
#pragma unroll
    for (int i = 0; i < 2; ++i) { int R, C; stage_rc(tid * 16 + i * 8192, R, C); const int Rb = Epi::PERM ? ((R & ~31) + perm32(R & 31)) : R;
        voffA[i] = (unsigned)(R * K + C) * 2u; voffB[i] = (unsigned)(Rb * K + C) * 2u; }
    const size_t kstep = (size_t)(BK * 2);
    const size_t hstep = (size_t)HALF * K * 2;
    const size_t tstep = 2 * hstep;
    const unsigned ldsw = (unsigned)wid * 1024u;
    const int aoff = lds_byte(wr * 64 + fr, fq * 8), boff = lds_byte(wc * 32 + fr, fq * 8);
#define PG8_SA(b, h) (((b) * 2 + (h)) * HTB)
#define PG8_SB(b, h) ((4 + (b) * 2 + (h)) * HTB)
#define PG8_STAGE(bufoff, gbase, voff) do { _Pragma("unroll") for (int _i = 0; _i < 2; ++_i) \
        __builtin_amdgcn_global_load_lds((const unsigned*)((const char*)(gbase) + (voff)[_i]), (PG8_LAS unsigned*)(lds + (bufoff) + ldsw + _i * 8192), 16, 0, 0); } while (0)
#define PG8_LDA(dst, b, h) do { _Pragma("unroll") for (int m = 0; m < 4; ++m) _Pragma("unroll") for (int k = 0; k < 2; ++k) dst[m][k] = *(const PG8_LAS bf16x8*)(lds + PG8_SA(b, h) + aoff + m * 2048 + k * 1024); } while (0)
#define PG8_LDB(dst, b, h) do { _Pragma("unroll") for (int n = 0; n < 2; ++n) _Pragma("unroll") for (int k = 0; k < 2; ++k) dst[n][k] = *(const PG8_LAS bf16x8*)(lds + PG8_SB(b, h) + boff + n * 2048 + k * 1024); } while (0)
#define PG8_MMA(ai, bj, At, Bt) do { __builtin_amdgcn_s_setprio(1); _Pragma("unroll") for (int m = 0; m < 4; ++m) _Pragma("unroll") for (int n = 0; n < 2; ++n) _Pragma("unroll") for (int k = 0; k < 2; ++k) \
        acc[ai][bj][m][n] = __builtin_amdgcn_mfma_f32_16x16x32_bf16(Bt[n][k], At[m][k], acc[ai][bj][m][n], 0, 0, 0); __builtin_amdgcn_s_setprio(0); } while (0)
#define PG8_WAIT_V(n) asm volatile("s_waitcnt vmcnt(" #n ")" ::: "memory")
#define PG8_WAIT_L(n) asm volatile("s_waitcnt lgkmcnt(" #n ")" ::: "memory")
#define PG8_BAR __builtin_amdgcn_s_barrier()
#define PG8_SCHED __builtin_amdgcn_sched_barrier(0)
    Unit cur, nxt; int ui = 0;
    if (!S.next(0, cur)) return;
    f32x4 acc[2][2][4][2];
#pragma unroll
    for (int a = 0; a < 2; ++a)
#pragma unroll
        for (int b = 0; b < 2; ++b)
#pragma unroll
            for (int m = 0; m < 4; ++m)
#pragma unroll
                for (int n = 0; n < 2; ++n) acc[a][b][m][n] = (f32x4){0.f, 0.f, 0.f, 0.f};
    bf16x8 At[4][2], B0[2][2], B1[2][2];
    const char* cA = (const char*)g.A + (size_t)cur.pm * tstep; const char* cB = (const char*)g.Bt + (size_t)cur.pn * tstep;
    S.a_ready(cur);
    if constexpr (SP2) {
        PG8_STAGE(PG8_SB(0, 0), cB, voffB); PG8_STAGE(PG8_SB(0, 1), cB + hstep, voffB); PG8_STAGE(PG8_SA(0, 0), cA, voffA); PG8_STAGE(PG8_SA(0, 1), cA + hstep, voffA);
        if (wr == 1) PG8_BAR;
        PG8_WAIT_V(2); PG8_BAR;
        PG8_STAGE(PG8_SB(1, 0), cB + kstep, voffB); PG8_STAGE(PG8_SA(1, 0), cA + kstep, voffA); PG8_STAGE(PG8_SB(1, 1), cB + hstep + kstep, voffB);
        PG8_WAIT_V(6); PG8_BAR;
    } else {
        PG8_STAGE(PG8_SB(0, 0), cB, voffB); PG8_STAGE(PG8_SA(0, 0), cA, voffA); PG8_STAGE(PG8_SB(0, 1), cB + hstep, voffB); PG8_STAGE(PG8_SA(0, 1), cA + hstep, voffA);
        if (wr == 1) PG8_BAR;
        PG8_WAIT_V(4); PG8_BAR;
        PG8_STAGE(PG8_SB(1, 0), cB + kstep, voffB); PG8_STAGE(PG8_SA(1, 0), cA + kstep, voffA); PG8_STAGE(PG8_SB(1, 1), cB + hstep + kstep, voffB);
        PG8_WAIT_V(6); PG8_BAR;
    }
    for (;;) {
        const bool has_next = S.next(ui + 1, nxt);
        const char* nA = has_next ? (const char*)g.A + (size_t)nxt.pm * tstep : cA; const char* nB = has_next ? (const char*)g.Bt + (size_t)nxt.pn * tstep : cB;
        for (int t = 0; t < nt; t += 2) {
            const bool last = (t == nt - 2);
            const char* a1 = cA + (size_t)(t + 1) * kstep;
            const char* a2 = last ? nA : cA + (size_t)(t + 2) * kstep; const char* b2 = last ? nB : cB + (size_t)(t + 2) * kstep;
            const char* a3 = a2 + kstep; const char* b3 = b2 + kstep;
            if (last && has_next) S.a_ready(nxt);
            if constexpr (SP2) {
            PG8_LDB(B0, 0, 0); PG8_LDB(B1, 0, 1); PG8_SCHED; PG8_LDA(At, 0, 0); PG8_STAGE(PG8_SA(1, 1), a1 + hstep, voffA);
            PG8_WAIT_V(8); PG8_WAIT_L(0); PG8_BAR; PG8_MMA(0, 0, At, B0); PG8_MMA(0, 1, At, B1); PG8_BAR; PG8_SCHED;
            PG8_LDA(At, 0, 1); PG8_STAGE(PG8_SB(0, 0), b2, voffB); PG8_STAGE(PG8_SB(0, 1), b2 + hstep, voffB); PG8_STAGE(PG8_SA(0, 0), a2, voffA);
            PG8_WAIT_V(8); PG8_WAIT_L(0); PG8_BAR; PG8_MMA(1, 0, At, B0); PG8_MMA(1, 1, At, B1); PG8_BAR; PG8_SCHED;
            PG8_LDB(B0, 1, 0); PG8_LDB(B1, 1, 1); PG8_SCHED; PG8_LDA(At, 1, 0); PG8_STAGE(PG8_SA(0, 1), a2 + hstep, voffA);
            PG8_WAIT_V(8); PG8_WAIT_L(0); PG8_BAR; PG8_MMA(0, 0, At, B0); PG8_MMA(0, 1, At, B1); PG8_BAR; PG8_SCHED;
            PG8_LDA(At, 1, 1); PG8_STAGE(PG8_SB(1, 0), b3, voffB); PG8_STAGE(PG8_SB(1, 1), b3 + hstep, voffB); PG8_STAGE(PG8_SA(1, 0), a3, voffA);
            PG8_WAIT_V(8); PG8_WAIT_L(0); PG8_BAR; PG8_MMA(1, 0, At, B0); PG8_MMA(1, 1, At, B1); PG8_BAR; PG8_SCHED;
            } else {
            PG8_LDB(B0, 0, 0); PG8_SCHED; PG8_LDA(At, 0, 0); PG8_STAGE(PG8_SA(1, 1), a1 + hstep, voffA);
            PG8_WAIT_L(8); PG8_BAR; PG8_WAIT_L(0); PG8_MMA(0, 0, At, B0); PG8_BAR; PG8_SCHED;
            PG8_LDB(B1, 0, 1); PG8_STAGE(PG8_SB(0, 0), b2, voffB);
            PG8_BAR; PG8_WAIT_L(0); PG8_MMA(0, 1, At, B1); PG8_BAR;
            PG8_LDA(At, 0, 1); PG8_STAGE(PG8_SA(0, 0), a2, voffA);
            PG8_BAR; PG8_WAIT_L(0); PG8_MMA(1, 0, At, B0); PG8_BAR; PG8_SCHED;
            PG8_STAGE(PG8_SB(0, 1), b2 + hstep, voffB);
            PG8_WAIT_V(6); PG8_BAR; PG8_MMA(1, 1, At, B1); PG8_BAR;
            PG8_LDB(B0, 1, 0); PG8_SCHED; PG8_LDA(At, 1, 0); PG8_STAGE(PG8_SA(0, 1), a2 + hstep, voffA);
            PG8_WAIT_L(8); PG8_BAR; PG8_WAIT_L(0); PG8_MMA(0, 0, At, B0); PG8_BAR; PG8_SCHED;
            PG8_LDB(B1, 1, 1); PG8_STAGE(PG8_SB(1, 0), b3, voffB);
            PG8_BAR; PG8_WAIT_L(0); PG8_MMA(0, 1, At, B1); PG8_BAR;
            PG8_LDA(At, 1, 1); PG8_STAGE(PG8_SA(1, 0), a3, voffA);
            PG8_BAR; PG8_WAIT_L(0); PG8_MMA(1, 0, At, B0); PG8_BAR; PG8_SCHED;
            PG8_STAGE(PG8_SB(1, 1), b3 + hstep, voffB);
            PG8_WAIT_V(6); PG8_BAR; PG8_MMA(1, 1, At, B1); PG8_BAR;
            }
        }
        if constexpr (ALIGN_EPI) { if (wr == 0) PG8_BAR; }
        if constexpr (!Epi::AFTER_DRAIN) { E(acc, cur, wr, wc, fr, fq); S.done(cur); }
        if (!has_next) break;
#pragma unroll
        for (int a = 0; a < 2; ++a)
#pragma unroll
            for (int b = 0; b < 2; ++b)
#pragma unroll
                for (int m = 0; m < 4; ++m)
#pragma unroll
                    for (int n = 0; n < 2; ++n) acc[a][b][m][n] = (f32x4){0.f, 0.f, 0.f, 0.f};
        cur = nxt; cA = nA; cB = nB; ++ui;
        if constexpr (ALIGN_EPI) { if (wr == 1) PG8_BAR; }
    }
    PG8_WAIT_V(0);
    if constexpr (!ALIGN_EPI) { if (wr == 0) PG8_BAR; }
    PG8_BAR;
    if constexpr (Epi::AFTER_DRAIN) { E.fused(acc, cur, wr, wc, fr, fq, lds, wid, lane); S.done(cur); }
#undef PG8_SA
#undef PG8_SB
#undef PG8_STAGE
#undef PG8_LDA
#undef PG8_LDB
#undef PG8_MMA
#undef PG8_WAIT_V
#undef PG8_WAIT_L
#undef PG8_BAR
#undef PG8_SCHED
}
}

#define GAS __attribute__((address_space(1)))
#define LAS __attribute__((address_space(3)))
typedef unsigned short bf16;
typedef unsigned v4u __attribute__((ext_vector_type(4)));
typedef float f32x4 __attribute__((ext_vector_type(4)));
typedef short bf16x8 __attribute__((ext_vector_type(8)));
typedef GAS unsigned gu32;
typedef GAS unsigned long long gu64;
#define RLX_AGENT __ATOMIC_RELAXED, __HIP_MEMORY_SCOPE_AGENT
#define LDS_WAIT() asm volatile("s_waitcnt lgkmcnt(0)" ::: "memory")
#define VM_WAIT() asm volatile("s_waitcnt vmcnt(0)" ::: "memory")
__device__ __forceinline__ unsigned long long rt() { return __builtin_amdgcn_s_memrealtime(); }
__device__ __forceinline__ unsigned f2bf(float f) { unsigned u = __builtin_bit_cast(unsigned, f); return (u + 0x7fffu + ((u >> 16) & 1u)) >> 16; }
__device__ __forceinline__ unsigned pk2(float lo, float hi) { return f2bf(lo) | (f2bf(hi) << 16); }

__device__ __forceinline__ int lane_id_v() { int l; asm volatile("v_mbcnt_lo_u32_b32 %0, -1, 0\n\tv_mbcnt_hi_u32_b32 %0, -1, %0" : "=v"(l)); return l; }

template <int CTRL> __device__ __forceinline__ float dppf(float x) { return __builtin_bit_cast(float, __builtin_amdgcn_mov_dpp(__builtin_bit_cast(int, x), CTRL, 0xf, 0xf, true)); }
constexpr int DPP_XOR1 = 0xB1, DPP_XOR2 = 0x4E, DPP_XOR7 = 0x141, DPP_XOR8 = 0x128;
__device__ __forceinline__ float row16_sum(float x) { x += dppf<DPP_XOR1>(x); x += dppf<DPP_XOR2>(x); x += dppf<DPP_XOR7>(x); x += dppf<DPP_XOR8>(x); return x; }
__device__ __forceinline__ float swap16_sum(float x) { auto s = __builtin_amdgcn_permlane16_swap(__float_as_uint(x), __float_as_uint(x), false, false); return __uint_as_float(s[0]) + __uint_as_float(s[1]); }
__device__ __forceinline__ float swap32_sum(float x) { auto s = __builtin_amdgcn_permlane32_swap(__float_as_uint(x), __float_as_uint(x), false, false); return __uint_as_float(s[0]) + __uint_as_float(s[1]); }
__device__ __forceinline__ float swap32_max(float x) { auto s = __builtin_amdgcn_permlane32_swap(__float_as_uint(x), __float_as_uint(x), false, false); return fmaxf(__uint_as_float(s[0]), __uint_as_float(s[1])); }
__device__ __forceinline__ float other16(float x, bool odd_row) { auto s = __builtin_amdgcn_permlane16_swap(__float_as_uint(x), __float_as_uint(x), false, false); return __uint_as_float(odd_row ? s[0] : s[1]); }

#define XB_TMO      128
#define XB_XCNT(j)  (256  + 64 * (j))
#define XB_XSUB(j)  (1280 + 64 * (j))
#define XB_XGEN(j)  (2304 + 64 * (j))
#define XB_TOP      3328
#define XB_TOPGEN   3392
#define XCD_BAR_WORDS 3456
#define XB_SPIN_CAP (1u << 18)

__device__ __forceinline__ unsigned xb_ld(unsigned* p)              { return __hip_atomic_load(p, __ATOMIC_RELAXED, __HIP_MEMORY_SCOPE_AGENT); }
__device__ __forceinline__ unsigned xb_add(unsigned* p, unsigned v) { return __hip_atomic_fetch_add(p, v, __ATOMIC_RELAXED, __HIP_MEMORY_SCOPE_AGENT); }
__device__ __forceinline__ unsigned xb_xcc_id() { return (unsigned)__builtin_amdgcn_s_getreg((3 << 11) | 20) & 0xFu; }
#define XB_SPIN(cond, bar) do { unsigned _sp = 0; while (cond) { __builtin_amdgcn_s_sleep(1); \
    if ((++_sp & 255u) == 0u) { if (xb_ld(&(bar)[XB_TMO])) break; if (_sp > XB_SPIN_CAP) { atomicAdd(&(bar)[XB_TMO], 1u); break; } } } } while (0)

struct XcdBarrier {
    unsigned* bar; unsigned x; unsigned wv;
    volatile LAS unsigned* st;
};

#define XB_IS_T0(b) ((b).wv == 0u && lane_id_v() == 0)
__device__ __forceinline__ XcdBarrier xcd_barrier_post(unsigned* bar, volatile LAS unsigned* st, unsigned wv) {
    XcdBarrier b; b.bar = bar; b.x = xb_xcc_id(); b.st = st; b.wv = wv;
    if (XB_IS_T0(b)) (void)xb_add(&bar[XB_XCNT(b.x)], 1u);
    return b;
}
__device__ __forceinline__ void xcd_barrier_complete(unsigned* bar, unsigned x, unsigned& nloc, unsigned& nx) {
    const unsigned G = gridDim.x * gridDim.y * gridDim.z;
    unsigned sum, cnt, mine, sp = 0u;
    for (;;) {
        sum = 0u; cnt = 0u; mine = 0u;
#pragma unroll
        for (unsigned j = 0; j < 16; ++j) { const unsigned c = xb_ld(&bar[XB_XCNT(j)]); sum += c; cnt += (c > 0u) ? 1u : 0u; mine = (j == x) ? c : mine; }
        if (sum == G) break;
        __builtin_amdgcn_s_sleep(1);
        if ((++sp & 255u) == 0u) { if (xb_ld(&bar[XB_TMO])) break; if (sp > XB_SPIN_CAP) { atomicAdd(&bar[XB_TMO], 1u); break; } }
    }
    nloc = mine > 0u ? mine : 1u; nx = cnt > 0u ? cnt : 1u;
}

__device__ __forceinline__ void xcd_barrier(const XcdBarrier& b) {
    asm volatile("s_waitcnt vmcnt(0)" ::: "memory");
    __syncthreads();
    if (XB_IS_T0(b)) {
        unsigned* bar = b.bar;
        __builtin_amdgcn_s_waitcnt(0);
        unsigned nloc = b.st[0], nx = b.st[1];
        if (nloc == 0u) { xcd_barrier_complete(bar, b.x, nloc, nx); b.st[0] = nloc; b.st[1] = nx; }
        const unsigned old = xb_add(&bar[XB_XSUB(b.x)], 1u);
        const unsigned gen = old / nloc;
        if (old + 1u == (gen + 1u) * nloc) {
            __builtin_amdgcn_fence(__ATOMIC_RELEASE, "agent");
            asm volatile("s_waitcnt vmcnt(0)" ::: "memory");
            const unsigned og = xb_add(&bar[XB_TOP], 1u);
            const unsigned tg = og / nx;
            if (og + 1u == (tg + 1u) * nx) xb_add(&bar[XB_TOPGEN], 1u);
            else XB_SPIN(xb_ld(&bar[XB_TOPGEN]) == tg, bar);
            __builtin_amdgcn_fence(__ATOMIC_ACQUIRE, "agent");
            xb_add(&bar[XB_XGEN(b.x)], 1u);
            asm volatile("s_waitcnt vmcnt(0)" ::: "memory");
        } else {
            XB_SPIN(xb_ld(&bar[XB_XGEN(b.x)]) == gen, bar);
            __builtin_amdgcn_fence(__ATOMIC_ACQUIRE, "agent");
            asm volatile("s_waitcnt vmcnt(0)" ::: "memory");
        }
    }
    __syncthreads();
}


constexpr int NWAVES = 8;
constexpr int DM = 1024, NB = 8, SEQ = 2048, DB = 32, DS = 4, PAST = 8192, PAGE = 128, NPAGES = 64;
constexpr int DA = 512, DC = 512, NH = 4, HD = 64, VD = 128, CW = 31, DFF = 4096, DPLE = 256, NIN = 2560;
constexpr int MP = NB * SEQ;
constexpr int MS = DB * DS;
constexpr int MR = MP + MS;
constexpr int MT = 16640;
constexpr float EPS = 1e-6f;
constexpr float LOG2E = 1.4426950408889634f;
constexpr float C2 = 0.125f * LOG2E;
constexpr float LAM_INIT = 0.2f;
constexpr size_t O_YP = 0, O_YS = O_YP + (size_t)MP * DM, O_KP = O_YS + (size_t)MS * DM, O_VP = O_KP + (size_t)MP * DA,
                 O_CP = O_VP + (size_t)MP * DA, O_KS = O_CP + (size_t)NB * 30 * DC, O_VS = O_KS + (size_t)MS * DA, O_CS = O_VS + (size_t)MS * DA,
                 O_END = O_CS + (size_t)DB * 30 * DC;
static_assert(O_END == 34430976, "output size");
constexpr size_t MiB = 1u << 20;
constexpr size_t al1(size_t x) { return (x + MiB - 1) / MiB * MiB; }
constexpr size_t WS_CTL = 0, CTL_ZERO_BYTES = 1 * MiB;
constexpr size_t WS_WIN = 1 * MiB;
constexpr size_t WS_WOUT = WS_WIN + al1((size_t)NIN * DM * 2);
constexpr size_t WS_WFF1 = WS_WOUT + al1((size_t)DM * DM * 2);
constexpr size_t WS_WFF2 = WS_WFF1 + al1((size_t)DFF * DM * 2);
constexpr size_t WS_WGATE = WS_WFF2 + al1((size_t)DFF * DM * 2);
constexpr size_t WS_WPLE = WS_WGATE + al1((size_t)DM * DM * 2);
constexpr size_t WS_XN = WS_WPLE + al1((size_t)DM * DPLE * 2);
constexpr size_t WS_Q = WS_XN + al1((size_t)MT * DM * 2);
constexpr size_t WS_K = WS_Q + al1((size_t)MT * DA * 2);
constexpr size_t WS_V = WS_K + al1((size_t)MT * DA * 2);
constexpr size_t WS_U = WS_V + al1((size_t)MT * DA * 2);
constexpr size_t WS_Y2 = WS_U + al1((size_t)MT * DC * 2);
constexpr size_t WS_MM = WS_Y2 + al1((size_t)MT * DM * 2);
constexpr size_t WS_H = WS_MM + al1((size_t)MT * DM * 4);
constexpr size_t WS_HN = WS_H + al1((size_t)MT * DM * 4);
constexpr size_t WS_HH = WS_HN + al1((size_t)MT * DM * 2);
constexpr size_t WS_FF = WS_HH + al1((size_t)MT * DFF * 2);
constexpr size_t WS_H2 = WS_FF + al1((size_t)MT * DM * 4);
constexpr size_t WS_H2B = WS_H2 + al1((size_t)MT * DM * 4);
constexpr size_t WS_PE = WS_H2B + al1((size_t)MT * DM * 2);
constexpr size_t WS_E = WS_PE + al1((size_t)MT * DPLE * 2);
constexpr size_t WS_QS = WS_E + al1((size_t)MT * DM * 2);
constexpr int DSPLIT = 2, PREC = 132;
constexpr size_t WS_DP = WS_QS + al1((size_t)MS * DA * 4);
constexpr size_t WS_END = WS_DP + al1((size_t)DB * NH * DSPLIT * 2 * DS * PREC * 4);
constexpr int CW_TMO = 0, CW_CODE = 1, CW_BAR = 4096;

constexpr int RING_OFF = 0, RING_BYTES = 131072;
constexpr int LDSCTL_OFF = RING_BYTES, MISC_OFF = LDSCTL_OFF + 320;
constexpr int LDS_BYTES = 147456;
static_assert(MISC_OFF + 128 <= LDS_BYTES, "LDS map");


__device__ __forceinline__ float sigmoidf_fast(float x) { return __builtin_amdgcn_rcpf(1.0f + __builtin_amdgcn_exp2f(-x * LOG2E)); }
__device__ __forceinline__ v4u pack8(const f32x4& a, const f32x4& b) { v4u w; w.x = pg8::cvt_pk_bf16(a[0], a[1]); w.y = pg8::cvt_pk_bf16(a[2], a[3]); w.z = pg8::cvt_pk_bf16(b[0], b[1]); w.w = pg8::cvt_pk_bf16(b[2], b[3]); return w; }

struct EpiIn {
    static constexpr bool PERM = true, AFTER_DRAIN = false;
    bf16* Qb; bf16* Kb; bf16* Vb; bf16* Ub; float* QS; float* out;
    __device__ __forceinline__ void operator()(const f32x4 (&acc)[2][2][4][2], const pg8::Unit& u, int wr, int wc, int fr, int fq) const {
        const int pn = u.pn;
        const int rbase = u.pm * 256 + wr * 64 + fr;
        const int cl = wc * 32 + 8 * fq;
        if (pn < 6) {
            const int kind = pn >> 1, colh = (pn & 1) * 256;
#pragma unroll
            for (int ai = 0; ai < 2; ++ai)
#pragma unroll
                for (int m = 0; m < 4; ++m) {
                    const int row = rbase + ai * 128 + m * 16;
                    if (row < MR) {
#pragma unroll
                        for (int bj = 0; bj < 2; ++bj) {
                            const int col = colh + bj * 128 + cl;
                            f32x4 v0 = acc[ai][bj][m][0], v1 = acc[ai][bj][m][1];
                            if (kind == 0) {
                                v0 = v0 * C2; v1 = v1 * C2;
                                *(v4u*)(Qb + (size_t)row * DA + col) = pack8(v0, v1);
                                if (row >= MP) { float* q = QS + (size_t)(row - MP) * DA + col; *(f32x4*)q = v0; *(f32x4*)(q + 4) = v1; }
                            } else {
                                bf16* B = (kind == 1) ? Kb : Vb;
                                *(v4u*)(B + (size_t)row * DA + col) = pack8(v0, v1);
                                float* o = (row < MP) ? out + (kind == 1 ? O_KP : O_VP) + (size_t)row * DA + col
                                                      : out + (kind == 1 ? O_KS : O_VS) + (size_t)(row - MP) * DA + col;
                                *(f32x4*)o = v0; *(f32x4*)(o + 4) = v1;
                            }
                        }
                    }
                }
        } else {
            const int ch = (pn - 6) * 128 + cl;
#pragma unroll
            for (int ai = 0; ai < 2; ++ai)
#pragma unroll
                for (int m = 0; m < 4; ++m) {
                    const int row = rbase + ai * 128 + m * 16;
                    if (row < MR) {
                        f32x4 u0, u1;
#pragma unroll
                        for (int i = 0; i < 4; ++i) { u0[i] = acc[ai][0][m][0][i] * sigmoidf_fast(acc[ai][1][m][0][i]); u1[i] = acc[ai][0][m][1][i] * sigmoidf_fast(acc[ai][1][m][1][i]); }
                        *(v4u*)(Ub + (size_t)row * DC + ch) = pack8(u0, u1);
                        float* cs = nullptr;
                        if (row < MP) { const int t = row & (SEQ - 1); if (t >= SEQ - 30) cs = out + O_CP + ((size_t)(row >> 11) * 30 + (t - (SEQ - 30))) * DC + ch; }
                        else { const int r = row - MP; cs = out + O_CS + ((size_t)(r >> 2) * 30 + 26 + (r & 3)) * DC + ch; }
                        if (cs) { *(f32x4*)cs = u0; *(f32x4*)(cs + 4) = u1; }
                    }
                }
        }
    }
};
struct EpiF32 {
    static constexpr bool PERM = true, AFTER_DRAIN = false;
    float* O; int ldc;
    __device__ __forceinline__ void operator()(const f32x4 (&acc)[2][2][4][2], const pg8::Unit& u, int wr, int wc, int fr, int fq) const {
        const int rbase = u.pm * 256 + wr * 64 + fr, cb = u.pn * 256 + wc * 32 + 8 * fq;
#pragma unroll
        for (int ai = 0; ai < 2; ++ai)
#pragma unroll
            for (int m = 0; m < 4; ++m) { float* rp = O + (size_t)(rbase + ai * 128 + m * 16) * ldc + cb;
#pragma unroll
                for (int bj = 0; bj < 2; ++bj) { *(f32x4*)(rp + bj * 128) = acc[ai][bj][m][0]; *(f32x4*)(rp + bj * 128 + 4) = acc[ai][bj][m][1]; } }
    }
};
template <int ACT> struct EpiB16 {
    static constexpr bool PERM = true, AFTER_DRAIN = false;
    bf16* O; int ldc;
    __device__ __forceinline__ void operator()(const f32x4 (&acc)[2][2][4][2], const pg8::Unit& u, int wr, int wc, int fr, int fq) const {
        const int rbase = u.pm * 256 + wr * 64 + fr, cb = u.pn * 256 + wc * 32 + 8 * fq;
#pragma unroll
        for (int ai = 0; ai < 2; ++ai)
#pragma unroll
            for (int m = 0; m < 4; ++m) { bf16* rp = O + (size_t)(rbase + ai * 128 + m * 16) * ldc + cb;
#pragma unroll
                for (int bj = 0; bj < 2; ++bj) { f32x4 v0 = acc[ai][bj][m][0], v1 = acc[ai][bj][m][1];
                    if (ACT == 1) {
#pragma unroll
                        for (int i = 0; i < 4; ++i) { const float a = fmaxf(v0[i], 0.f), b = fmaxf(v1[i], 0.f); v0[i] = a * a; v1[i] = b * b; } }
                    *(v4u*)(rp + bj * 128) = pack8(v0, v1); } }
    }
};
struct EpiGate {
    static constexpr bool PERM = true, AFTER_DRAIN = false;
    const float* H2; const bf16* E; float* out;
    __device__ __forceinline__ void operator()(const f32x4 (&acc)[2][2][4][2], const pg8::Unit& u, int wr, int wc, int fr, int fq) const {
        const int rbase = u.pm * 256 + wr * 64 + fr, cb = u.pn * 256 + wc * 32 + 8 * fq;
#pragma unroll
        for (int ai = 0; ai < 2; ++ai)
#pragma unroll
            for (int m = 0; m < 4; ++m) {
                const int row = rbase + ai * 128 + m * 16;
                if (row < MR) {
                    float* op = (row < MP) ? out + O_YP + (size_t)row * DM + cb : out + O_YS + (size_t)(row - MP) * DM + cb;
#pragma unroll
                    for (int bj = 0; bj < 2; ++bj) {
                        const f32x4 h0 = *(const f32x4*)(H2 + (size_t)row * DM + cb + bj * 128), h1 = *(const f32x4*)(H2 + (size_t)row * DM + cb + bj * 128 + 4);
                        const v4u ev = *(const v4u*)(E + (size_t)row * DM + cb + bj * 128);
                        f32x4 e0, e1;
                        e0[0] = __uint_as_float(ev.x << 16); e0[1] = __uint_as_float(ev.x & 0xffff0000u); e0[2] = __uint_as_float(ev.y << 16); e0[3] = __uint_as_float(ev.y & 0xffff0000u);
                        e1[0] = __uint_as_float(ev.z << 16); e1[1] = __uint_as_float(ev.z & 0xffff0000u); e1[2] = __uint_as_float(ev.w << 16); e1[3] = __uint_as_float(ev.w & 0xffff0000u);
                        f32x4 y0, y1;
#pragma unroll
                        for (int i = 0; i < 4; ++i) { y0[i] = h0[i] + sigmoidf_fast(acc[ai][bj][m][0][i]) * e0[i]; y1[i] = h1[i] + sigmoidf_fast(acc[ai][bj][m][1][i]) * e1[i]; }
                        *(f32x4*)(op + bj * 128) = y0; *(f32x4*)(op + bj * 128 + 4) = y1;
                    }
                }
            }
    }
};


struct Frame {
    LAS unsigned char* lds;
    volatile LAS unsigned* MISC;
    gu32* ctl;
    int tid, lane, wave;
    int vcu, G;
};
__device__ __forceinline__ float wave_sum(float v) { return swap32_sum(swap16_sum(row16_sum(v))); }
__device__ __forceinline__ float bf_lo(unsigned w) { return __uint_as_float(w << 16); }
__device__ __forceinline__ float bf_hi(unsigned w) { return __uint_as_float(w & 0xffff0000u); }
__device__ __forceinline__ float alibi_slope2(int h) { return LOG2E * (h == 0 ? 0.25f : h == 1 ? 0.0625f : h == 2 ? 0.015625f : 0.00390625f); }
__device__ __forceinline__ float diff_lambda(const float* q1, const float* k1, const float* q2, const float* k2, int lane) {
    const float a = wave_sum(q1[lane] * k1[lane]), b = wave_sum(q2[lane] * k2[lane]);
    return __expf(a) - __expf(b) + LAM_INIT;
}

__device__ __forceinline__ void p0_transpose_item(const float* W, int K, int N, bf16* WT, int k0, int n0, int drow0, LAS float* scr, int lane) {
#pragma unroll 8
    for (int i = 0; i < 32; ++i) { const int kk = 2 * i + (lane >> 5); scr[kk * 33 + (lane & 31)] = W[(size_t)(k0 + kk) * N + n0 + (lane & 31)]; }
    LDS_WAIT(); asm volatile("" ::: "memory");
    const int c = lane & 7;
#pragma unroll
    for (int j = 0; j < 4; ++j) { const int n = (lane >> 3) + 8 * j; const LAS float* s = scr + (8 * c) * 33 + n;
        v4u o; o.x = pk2(s[0 * 33], s[1 * 33]); o.y = pk2(s[2 * 33], s[3 * 33]); o.z = pk2(s[4 * 33], s[5 * 33]); o.w = pk2(s[6 * 33], s[7 * 33]);
        *(GAS v4u*)(WT + (size_t)(drow0 + n) * K + k0 + 8 * c) = o; }
    LDS_WAIT(); asm volatile("" ::: "memory");
}
__device__ __forceinline__ int win_dest_row(int n0) {
    if (n0 < 3 * DA) return n0;
    if (n0 < 3 * DA + DC) { const int ch = n0 - 3 * DA; return 3 * DA + (ch >> 7) * 256 + (ch & 127); }
    const int ch = n0 - 3 * DA - DC; return 3 * DA + (ch >> 7) * 256 + 128 + (ch & 127);
}
__device__ __forceinline__ const float* x_row(const float* xp, const float* xs, int m) { return m < MP ? xp + (size_t)m * DM : xs + (size_t)(m - MP) * DM; }
__device__ __forceinline__ void rms_row_to_bf16(const float* xrow, const float* g, bf16* orow, int lane) {
    const GAS f32x4* xr = (const GAS f32x4*)xrow + lane; const GAS f32x4* gr = (const GAS f32x4*)g + lane;
    f32x4 v[4]; float s = 0.f;
#pragma unroll
    for (int j = 0; j < 4; ++j) { v[j] = xr[64 * j]; s += (v[j].x * v[j].x + v[j].y * v[j].y) + (v[j].z * v[j].z + v[j].w * v[j].w); }
    const float r = 1.f / sqrtf(wave_sum(s) * (1.f / DM) + EPS);
    GAS unsigned long long* o8 = (GAS unsigned long long*)orow + lane;
#pragma unroll
    for (int j = 0; j < 4; ++j) { const f32x4 gg = gr[64 * j]; o8[64 * j] = (unsigned long long)pk2(v[j].x * r * gg.x, v[j].y * r * gg.y) | ((unsigned long long)pk2(v[j].z * r * gg.z, v[j].w * r * gg.w) << 32); }
}
__device__ __forceinline__ void post_mix_row(const float* mmrow, const float* xrow, const float* g1, const float* g2, float* hrow, bf16* hnrow, int lane) {
    const GAS f32x4* mr = (const GAS f32x4*)mmrow + lane; const GAS f32x4* xr = (const GAS f32x4*)xrow + lane;
    const GAS f32x4* g1r = (const GAS f32x4*)g1 + lane; const GAS f32x4* g2r = (const GAS f32x4*)g2 + lane;
    f32x4 v[4]; float s = 0.f;
#pragma unroll
    for (int j = 0; j < 4; ++j) { v[j] = mr[64 * j]; s += (v[j].x * v[j].x + v[j].y * v[j].y) + (v[j].z * v[j].z + v[j].w * v[j].w); }
    const float r1 = 1.f / sqrtf(wave_sum(s) * (1.f / DM) + EPS);
    float s2 = 0.f;
#pragma unroll
    for (int j = 0; j < 4; ++j) { v[j] = xr[64 * j] + v[j] * r1 * g1r[64 * j]; s2 += (v[j].x * v[j].x + v[j].y * v[j].y) + (v[j].z * v[j].z + v[j].w * v[j].w); }
    const float r2 = 1.f / sqrtf(wave_sum(s2) * (1.f / DM) + EPS);
    GAS f32x4* ho = (GAS f32x4*)hrow + lane; GAS unsigned long long* o8 = (GAS unsigned long long*)hnrow + lane;
#pragma unroll
    for (int j = 0; j < 4; ++j) { ho[64 * j] = v[j]; const f32x4 gg = g2r[64 * j];
        o8[64 * j] = (unsigned long long)pk2(v[j].x * r2 * gg.x, v[j].y * r2 * gg.y) | ((unsigned long long)pk2(v[j].z * r2 * gg.z, v[j].w * r2 * gg.w) << 32); }
}
__device__ __forceinline__ void post_ffn_row(const float* ffrow, const float* hrow, const float* g, float* h2row, bf16* h2brow, int lane) {
    const GAS f32x4* fr = (const GAS f32x4*)ffrow + lane; const GAS f32x4* hr = (const GAS f32x4*)hrow + lane; const GAS f32x4* gr = (const GAS f32x4*)g + lane;
    f32x4 v[4]; float s = 0.f;
#pragma unroll
    for (int j = 0; j < 4; ++j) { v[j] = fr[64 * j]; s += (v[j].x * v[j].x + v[j].y * v[j].y) + (v[j].z * v[j].z + v[j].w * v[j].w); }
    const float r1 = 1.f / sqrtf(wave_sum(s) * (1.f / DM) + EPS);
    GAS f32x4* ho = (GAS f32x4*)h2row + lane; GAS unsigned long long* o8 = (GAS unsigned long long*)h2brow + lane;
#pragma unroll
    for (int j = 0; j < 4; ++j) { const f32x4 y = hr[64 * j] + v[j] * r1 * gr[64 * j]; ho[64 * j] = y;
        o8[64 * j] = (unsigned long long)pk2(y.x, y.y) | ((unsigned long long)pk2(y.z, y.w) << 32); }
}
__device__ __forceinline__ void cvt_row256(const float* src, bf16* dst, int lane) {
    const f32x4 v = ((const GAS f32x4*)src)[lane];
    ((GAS unsigned long long*)dst)[lane] = (unsigned long long)pk2(v.x, v.y) | ((unsigned long long)pk2(v.z, v.w) << 32);
}

constexpr int CONV_WROWS = 37;
template <int KIND>
__device__ __forceinline__ void conv_group(const bf16* Ub, const float* state, float* cs_out, const LAS float* wl, const float* bdw, const float* lng, const float* lnb,
                                           bf16* Y2, int seq, int t0, int lane) {
    const int ch = 8 * lane;
    float acc[4][8];
    { const f32x4 b0 = *(const GAS f32x4*)(bdw + ch), b1 = *(const GAS f32x4*)(bdw + ch + 4);
#pragma unroll
      for (int o = 0; o < 4; ++o) { acc[o][0] = b0.x; acc[o][1] = b0.y; acc[o][2] = b0.z; acc[o][3] = b0.w; acc[o][4] = b1.x; acc[o][5] = b1.y; acc[o][6] = b1.z; acc[o][7] = b1.w; } }
    const size_t urow0 = (KIND == 0) ? (size_t)seq * SEQ : (size_t)MP + (size_t)seq * DS;
    const int i0 = (KIND == 0 && t0 < 30) ? 30 - t0 : 0;
#pragma unroll 2
    for (int i = i0; i < 34; ++i) {
        float u[8];
        if (KIND == 1 && i < 30) {
            const float* sp = state + ((size_t)seq * 30 + i) * DC + ch; const f32x4 a = *(const GAS f32x4*)sp, b = *(const GAS f32x4*)(sp + 4);
            u[0] = a.x; u[1] = a.y; u[2] = a.z; u[3] = a.w; u[4] = b.x; u[5] = b.y; u[6] = b.z; u[7] = b.w;
            if (i >= 4) { float* cp = cs_out + ((size_t)seq * 30 + (i - 4)) * DC + ch; *(GAS f32x4*)cp = a; *(GAS f32x4*)(cp + 4) = b; }
        } else {
            const size_t r = (KIND == 0) ? urow0 + (size_t)(t0 + i - 30) : urow0 + (size_t)(i - 30);
            const v4u w = *(const GAS v4u*)(Ub + r * DC + ch);
            u[0] = bf_lo(w.x); u[1] = bf_hi(w.x); u[2] = bf_lo(w.y); u[3] = bf_hi(w.y); u[4] = bf_lo(w.z); u[5] = bf_hi(w.z); u[6] = bf_lo(w.w); u[7] = bf_hi(w.w);
        }
        const LAS float* wr = wl + (i + 3) * DC + ch;
#pragma unroll
        for (int o = 0; o < 4; ++o) {
            const f32x4 w0 = *(const LAS f32x4*)(wr - o * DC), w1 = *(const LAS f32x4*)(wr - o * DC + 4);
            acc[o][0] = fmaf(w0.x, u[0], acc[o][0]); acc[o][1] = fmaf(w0.y, u[1], acc[o][1]); acc[o][2] = fmaf(w0.z, u[2], acc[o][2]); acc[o][3] = fmaf(w0.w, u[3], acc[o][3]);
            acc[o][4] = fmaf(w1.x, u[4], acc[o][4]); acc[o][5] = fmaf(w1.y, u[5], acc[o][5]); acc[o][6] = fmaf(w1.z, u[6], acc[o][6]); acc[o][7] = fmaf(w1.w, u[7], acc[o][7]);
        }
    }
    const f32x4 g0 = *(const GAS f32x4*)(lng + ch), g1 = *(const GAS f32x4*)(lng + ch + 4), c0 = *(const GAS f32x4*)(lnb + ch), c1 = *(const GAS f32x4*)(lnb + ch + 4);
    const float gg[8] = {g0.x, g0.y, g0.z, g0.w, g1.x, g1.y, g1.z, g1.w}, cc[8] = {c0.x, c0.y, c0.z, c0.w, c1.x, c1.y, c1.z, c1.w};
#pragma unroll
    for (int o = 0; o < 4; ++o) {
        float s = 0.f;
#pragma unroll
        for (int k = 0; k < 8; ++k) s += acc[o][k];
        const float mean = wave_sum(s) * (1.f / DC);
        float q = 0.f;
#pragma unroll
        for (int k = 0; k < 8; ++k) { const float d = acc[o][k] - mean; q = fmaf(d, d, q); }
        const float rstd = 1.f / sqrtf(wave_sum(q) * (1.f / DC) + EPS);
        float y[8];
#pragma unroll
        for (int k = 0; k < 8; ++k) { const float z = (acc[o][k] - mean) * rstd * gg[k] + cc[k]; y[k] = z * sigmoidf_fast(z); }
        v4u w; w.x = pk2(y[0], y[1]); w.y = pk2(y[2], y[3]); w.z = pk2(y[4], y[5]); w.w = pk2(y[6], y[7]);
        const size_t row = (KIND == 0) ? urow0 + t0 + o : urow0 + o;
        *(GAS v4u*)(Y2 + row * DM + DA + ch) = w;
    }
}


namespace att {
using bf16x8 = __attribute__((ext_vector_type(8))) short;
using s16x4  = __attribute__((ext_vector_type(4))) short;
using f32x16 = __attribute__((ext_vector_type(16))) float;
using u32x4  = __attribute__((ext_vector_type(4))) unsigned;
constexpr int KVBLK = 64, LD = 512;
constexpr int SHM_V = 64 * 128 * 2, SHM_K = 64 * 128 * 2;
constexpr int LDS_V = 0, LDS_K = 2 * SHM_V, LDS_WS = 2 * SHM_V + 2 * SHM_K, LDS_END = LDS_WS + 8 * 64 * 4;
constexpr float THR2 = 8.0f;
#define ASBAR() __builtin_amdgcn_sched_barrier(0)
__device__ __forceinline__ int crow(int r, int hi) { return (r & 3) + 8 * (r >> 2) + 4 * hi; }
__device__ __forceinline__ unsigned cvtpk(float lo, float hi) { unsigned r; asm volatile("v_cvt_pk_bf16_f32 %0, %1, %2" : "=v"(r) : "v"(lo), "v"(hi)); return r; }
__device__ __forceinline__ int k_st(int key, int ch16) { return ch16 * 1024 + ((key ^ (ch16 & 7)) << 4); }
__device__ __forceinline__ int v_st(int k, int c) { const int kk = (k & ~0xC) | ((k & 4) << 1) | ((k & 8) >> 1); return ((kk >> 3) * 4 + (c >> 5)) * 512 + ((kk & 7) * 32 + (c & 31)) * 2; }
__device__ __forceinline__ int v_rd_base(int lane) { return ((lane & 3) << 3) | (((lane >> 2) & 3) << 6) | (((lane >> 4) & 1) << 5) | (((lane >> 5) & 1) << 8); }
constexpr int v_rd_off(int d0, int ks, int half) { return d0 * 512 + ks * 4096 + half * 2048; }
template <int OFF> __device__ __forceinline__ s16x4 tr_read(int vb) { s16x4 r; asm volatile("ds_read_b64_tr_b16 %0, %1 offset:%2" : "=&v"(r) : "v"(vb), "i"(OFF) : "memory"); return r; }

__device__ __forceinline__ void partialSM(f32x16& p0, f32x16& p1, float& m_reg, float& alpha) {
  float pmax = p0[0];
#pragma unroll
  for (int r = 1; r < 16; ++r) pmax = fmaxf(pmax, p0[r]);
#pragma unroll
  for (int r = 0; r < 16; ++r) pmax = fmaxf(pmax, p1[r]);
  { auto rr = __builtin_amdgcn_permlane32_swap(__float_as_uint(pmax), __float_as_uint(pmax), false, false); pmax = fmaxf(__uint_as_float(rr[0]), __uint_as_float(rr[1])); }
  float mn;
  if (__builtin_expect(__all(pmax - m_reg <= THR2), 1)) { mn = m_reg; alpha = 1.f; }
  else { mn = fmaxf(m_reg, pmax); alpha = __builtin_amdgcn_exp2f(m_reg - mn); m_reg = mn; }
#pragma unroll
  for (int r = 0; r < 16; ++r) p0[r] = p0[r] - mn;
#pragma unroll
  for (int r = 0; r < 16; ++r) p1[r] = p1[r] - mn;
#pragma unroll
  for (int r = 0; r < 16; ++r) p0[r] = __builtin_amdgcn_exp2f(p0[r]);
}
__device__ __forceinline__ void finishSM(f32x16& p0, f32x16& p1, float alpha, float& l_reg, bf16x8& pa0, bf16x8& pa1, bf16x8& pa2, bf16x8& pa3) {
#pragma unroll
  for (int r = 0; r < 16; ++r) p1[r] = __builtin_amdgcn_exp2f(p1[r]);
  float ps = 0;
#pragma unroll
  for (int r = 0; r < 16; ++r) ps += p0[r];
#pragma unroll
  for (int r = 0; r < 16; ++r) ps += p1[r];
  { auto rr = __builtin_amdgcn_permlane32_swap(__float_as_uint(ps), __float_as_uint(ps), false, false); ps = __uint_as_float(rr[0]) + __uint_as_float(rr[1]); }
  l_reg = l_reg * alpha + ps;
#define PK4(P, BASE, OUT) do { unsigned a0 = cvtpk(P[BASE + 0], P[BASE + 1]), a1 = cvtpk(P[BASE + 2], P[BASE + 3]);   \
    unsigned b0 = cvtpk(P[BASE + 4], P[BASE + 5]), b1 = cvtpk(P[BASE + 6], P[BASE + 7]);                              \
    auto r0 = __builtin_amdgcn_permlane32_swap(a0, b0, false, false); auto r1 = __builtin_amdgcn_permlane32_swap(a1, b1, false, false); \
    u32x4 w = {r0[0], r1[0], r0[1], r1[1]}; OUT = *reinterpret_cast<bf16x8*>(&w); } while (0)
  PK4(p0, 0, pa0); PK4(p0, 8, pa1); PK4(p1, 0, pa2); PK4(p1, 8, pa3);
#undef PK4
}
__device__ __forceinline__ void qkt(f32x16& p0, f32x16& p1, const char* Ks, const bf16x8* qr, int r32, int hi, int comp, float slope2, float sb) {
#pragma unroll
  for (int r = 0; r < 16; ++r) { const float cr = (float)((r & 3) + 8 * (r >> 2)); p0[r] = fmaf(slope2, cr, sb); p1[r] = fmaf(slope2, cr + 32.f, sb); }
#pragma unroll
  for (int d0 = 0; d0 < 4; ++d0) { const int ch = comp * 8 + 2 * d0 + hi;
    const bf16x8 b0 = *reinterpret_cast<const bf16x8*>(Ks + k_st(r32, ch));
    const bf16x8 b1 = *reinterpret_cast<const bf16x8*>(Ks + k_st(32 + r32, ch));
    p0 = __builtin_amdgcn_mfma_f32_32x32x16_bf16(b0, qr[d0], p0, 0, 0, 0);
    p1 = __builtin_amdgcn_mfma_f32_32x32x16_bf16(b1, qr[d0], p1, 0, 0, 0); }
}
__device__ __forceinline__ void cmask(f32x16& p0, f32x16& p1, int krel, int qrel, int hi) {
  const int kb = krel + 4 * hi;
#pragma unroll
  for (int r = 0; r < 16; ++r) { const int kv = kb + (r & 3) + 8 * (r >> 2); if (kv > qrel) p0[r] = -INFINITY; if (kv + 32 > qrel) p1[r] = -INFINITY; }
}
template <int D0> __device__ __forceinline__ void pv_one(f32x16& od, int vb, bf16x8 pa0, bf16x8 pa1, bf16x8 pa2, bf16x8 pa3) {
  const s16x4 l0 = tr_read<v_rd_off(D0, 0, 0)>(vb), h0 = tr_read<v_rd_off(D0, 0, 1)>(vb), l1 = tr_read<v_rd_off(D0, 1, 0)>(vb), h1 = tr_read<v_rd_off(D0, 1, 1)>(vb);
  const s16x4 l2 = tr_read<v_rd_off(D0, 2, 0)>(vb), h2 = tr_read<v_rd_off(D0, 2, 1)>(vb), l3 = tr_read<v_rd_off(D0, 3, 0)>(vb), h3 = tr_read<v_rd_off(D0, 3, 1)>(vb);
  asm volatile("s_waitcnt lgkmcnt(0)" ::: "memory"); ASBAR();
#define PK(L, H) (bf16x8){L[0], L[1], L[2], L[3], H[0], H[1], H[2], H[3]}
  od = __builtin_amdgcn_mfma_f32_32x32x16_bf16(pa0, PK(l0, h0), od, 0, 0, 0);
  od = __builtin_amdgcn_mfma_f32_32x32x16_bf16(pa1, PK(l1, h1), od, 0, 0, 0);
  od = __builtin_amdgcn_mfma_f32_32x32x16_bf16(pa2, PK(l2, h2), od, 0, 0, 0);
  od = __builtin_amdgcn_mfma_f32_32x32x16_bf16(pa3, PK(l3, h3), od, 0, 0, 0);
#undef PK
}
__device__ __forceinline__ void pv_d0(f32x16* o, int vb, bf16x8 pa0, bf16x8 pa1, bf16x8 pa2, bf16x8 pa3) {
  pv_one<0>(o[0], vb, pa0, pa1, pa2, pa3); pv_one<1>(o[1], vb, pa0, pa1, pa2, pa3); pv_one<2>(o[2], vb, pa0, pa1, pa2, pa3); pv_one<3>(o[3], vb, pa0, pa1, pa2, pa3);
}

__device__ __forceinline__ void attn_unit(const unsigned short* __restrict__ Qb, const unsigned short* __restrict__ Kh, const unsigned short* __restrict__ Vh, unsigned short* __restrict__ Yb,
                                          int q0, float slope2, float lam, const float* __restrict__ gsub, char* lds, int tid_in) {
  int tid_ = tid_in; asm volatile("" : "+v"(tid_));
  const int tid = tid_, wid = tid >> 6, lane = tid & 63, r32 = lane & 31, hi = lane >> 5, comp = wid >> 2, w4 = wid & 3;
  char* V_lds = lds + LDS_V; char* K_lds = lds + LDS_K;
  float* wsf = (float*)(lds + LDS_WS) + wid * 64; float* li_l = wsf; float* al_l = wsf + 32;
  float m_reg = -1e30f, l_reg = 0.f; f32x16 o[4] = {}; bf16x8 qr[4];
  const unsigned short* Qw = Qb + (size_t)(w4 * 32 + r32) * LD + comp * 64 + hi * 8;
#pragma unroll
  for (int d0 = 0; d0 < 4; ++d0) qr[d0] = *reinterpret_cast<const bf16x8*>(Qw + d0 * 16);
  const int sr = tid >> 4, sc = (tid & 15) * 8;
  const int vst0 = v_st(sr, sc), vst1 = v_st(32 + sr, sc), kst0 = k_st(sr, tid & 15), kst1 = k_st(32 + sr, tid & 15);
  const int vb0 = (int)(uintptr_t)V_lds + v_rd_base(lane);
  struct { bf16x8 vs0, vs1, ks0, ks1; } sr_[1];
#define SLOAD(i, k0) do { sr_[i].vs0 = *reinterpret_cast<const bf16x8*>(&Vh[(size_t)((k0) + sr) * LD + sc]); sr_[i].vs1 = *reinterpret_cast<const bf16x8*>(&Vh[(size_t)((k0) + 32 + sr) * LD + sc]); \
    sr_[i].ks0 = *reinterpret_cast<const bf16x8*>(&Kh[(size_t)((k0) + sr) * LD + sc]); sr_[i].ks1 = *reinterpret_cast<const bf16x8*>(&Kh[(size_t)((k0) + 32 + sr) * LD + sc]); } while (0)
#define SWRITE(b, i) do { *(bf16x8*)(V_lds + (b) * SHM_V + vst0) = sr_[i].vs0; *(bf16x8*)(V_lds + (b) * SHM_V + vst1) = sr_[i].vs1; \
    *(bf16x8*)(K_lds + (b) * SHM_K + kst0) = sr_[i].ks0; *(bf16x8*)(K_lds + (b) * SHM_K + kst1) = sr_[i].ks1; } while (0)
#define SWAIT() asm volatile("s_waitcnt vmcnt(0)" ::: "memory")
#define RESC(a) do { if (__any((a) < 1.f)) { if (hi == 0) al_l[r32] = (a); asm volatile("s_waitcnt lgkmcnt(0)" ::: "memory"); \
    _Pragma("unroll") for (int d = 0; d < 4; ++d) _Pragma("unroll") for (int r = 0; r < 16; ++r) o[d][r] *= al_l[crow(r, hi)]; } } while (0)
  const int NT = (q0 + 128) / KVBLK;
  const int qrel = w4 * 32 + r32, qpos = q0 + qrel;
#define SB(t) (slope2 * (float)(64 * (t) + 4 * hi - qpos))
#define MASK(P0, P1, t) do { if ((t) >= NT - 2) cmask(P0, P1, 64 * (t) - q0, qrel, hi); } while (0)
  f32x16 pA0, pA1, pB0, pB1; float alA, alB; bf16x8 pa0, pa1, pa2, pa3;
  SLOAD(0, 0); asm volatile("s_waitcnt vmcnt(0)" ::: "memory"); SWRITE(0, 0); __syncthreads();
  qkt(pA0, pA1, K_lds, qr, r32, hi, comp, slope2, SB(0)); MASK(pA0, pA1, 0); partialSM(pA0, pA1, m_reg, alA);
  SLOAD(0, KVBLK);
  SWAIT(); SWRITE(1, 0); __syncthreads();
  for (int j = 1; j + 1 < NT; j += 2) {
    ASBAR(); qkt(pB0, pB1, K_lds + SHM_K, qr, r32, hi, comp, slope2, SB(j)); MASK(pB0, pB1, j);
    finishSM(pA0, pA1, alA, l_reg, pa0, pa1, pa2, pa3); ASBAR();
    SLOAD(0, (j + 1) * KVBLK); ASBAR();
    pv_d0(o, vb0, pa0, pa1, pa2, pa3); partialSM(pB0, pB1, m_reg, alB);
    __syncthreads(); SWAIT(); SWRITE(0, 0);
    RESC(alB); __syncthreads();
    ASBAR(); qkt(pA0, pA1, K_lds, qr, r32, hi, comp, slope2, SB(j + 1)); MASK(pA0, pA1, j + 1);
    finishSM(pB0, pB1, alB, l_reg, pa0, pa1, pa2, pa3); ASBAR();
    SLOAD(0, (j + 2) * KVBLK); ASBAR();
    pv_d0(o, vb0 + SHM_V, pa0, pa1, pa2, pa3); partialSM(pA0, pA1, m_reg, alA);
    __syncthreads(); SWAIT(); SWRITE(1, 0);
    RESC(alA); __syncthreads();
  }
  ASBAR(); qkt(pB0, pB1, K_lds + SHM_K, qr, r32, hi, comp, slope2, SB(NT - 1)); MASK(pB0, pB1, NT - 1);
  finishSM(pA0, pA1, alA, l_reg, pa0, pa1, pa2, pa3); ASBAR();
  pv_d0(o, vb0, pa0, pa1, pa2, pa3); partialSM(pB0, pB1, m_reg, alB);
  __syncthreads(); RESC(alB);
  finishSM(pB0, pB1, alB, l_reg, pa0, pa1, pa2, pa3); ASBAR();
  pv_d0(o, vb0 + SHM_V, pa0, pa1, pa2, pa3);
  int lane_e = lane_id_v();
  { const int r32 = lane_e & 31, hi = lane_e >> 5, lane = lane_e;
  if (hi == 0) li_l[r32] = l_reg; asm volatile("s_waitcnt lgkmcnt(0)" ::: "memory");
#pragma unroll
  for (int r = 0; r < 16; ++r) { const float rl = __builtin_amdgcn_rcpf(li_l[crow(r, hi)]);
#pragma unroll
    for (int d0 = 0; d0 < 4; ++d0) o[d0][r] *= rl; }
  __syncthreads();
  float* xch = (float*)lds + (size_t)w4 * 4096 + lane;
  if (comp == 1) {
#pragma unroll
    for (int d0 = 0; d0 < 4; ++d0)
#pragma unroll
      for (int r = 0; r < 16; ++r) xch[(d0 * 16 + r) * 64] = o[d0][r];
  }
  __syncthreads();
  if (comp == 0) {
    float ss[16];
#pragma unroll
    for (int r = 0; r < 16; ++r) ss[r] = 0.f;
#pragma unroll
    for (int d0 = 0; d0 < 4; ++d0)
#pragma unroll
      for (int r = 0; r < 16; ++r) { const float v = o[d0][r] - lam * xch[(d0 * 16 + r) * 64]; o[d0][r] = v; ss[r] = fmaf(v, v, ss[r]); }
#pragma unroll
    for (int r = 0; r < 16; ++r) {
      float s = ss[r];
      s = swap16_sum(row16_sum(s));
      ss[r] = (1.0f - LAM_INIT) / sqrtf(s * (1.0f / 128.0f) + EPS);
    }
    float g[4];
#pragma unroll
    for (int d0 = 0; d0 < 4; ++d0) g[d0] = gsub[d0 * 32 + r32];
    unsigned short* Yw = Yb + (size_t)(w4 * 32) * DM;
#pragma unroll
    for (int r = 0; r < 16; ++r) { const int orow = crow(r, hi);
#pragma unroll
      for (int d0 = 0; d0 < 4; ++d0) Yw[(size_t)orow * DM + d0 * 32 + r32] = (unsigned short)f2bf(o[d0][r] * ss[r] * g[d0]); }
  }
  }
  __syncthreads();
#undef SLOAD
#undef SWRITE
#undef SWAIT
#undef RESC
#undef SB
#undef MASK
}
#undef ASBAR
}


namespace dec {
constexpr int PPW = 4, CPP = PAGE / 16, NCH = PPW * CPP;
constexpr int MREC = 136;

__device__ __forceinline__ void decode_unit(const float* __restrict__ QS, const float* __restrict__ ck, const float* __restrict__ cv, const int* __restrict__ pt,
                                            float* __restrict__ part, int s, int h, int split, LAS float* mrg, int tid_in) {
    int tid_ = tid_in; asm volatile("" : "+v"(tid_));
    const int tid = tid_, lane = tid & 63, wave = __builtin_amdgcn_readfirstlane(tid >> 6), kk = lane >> 5, dl = lane & 31, comp = dl >> 4;
    const float slope2 = alibi_slope2(h);
    f32x4 Qr[DS];
#pragma unroll
    for (int q = 0; q < DS; ++q) Qr[q] = *(const GAS f32x4*)(QS + (size_t)(s * DS + q) * DA + h * 128 + dl * 4);
    float m[DS], l[DS]; f32x4 aown[DS], aoth[DS];
#pragma unroll
    for (int q = 0; q < DS; ++q) { m[q] = -1e30f; l[q] = 0.f; aown[q] = (f32x4){0.f, 0.f, 0.f, 0.f}; aoth[q] = (f32x4){0.f, 0.f, 0.f, 0.f}; }
    const int page0 = split * (NPAGES / DSPLIT) + wave * PPW;
    const size_t loff = (size_t)kk * DA + h * 128 + dl * 4;
    f32x4 Kn[8], Vn[8];
#define DISSUE(ci_) do { const int pg_ = page0 + ((ci_) >> 3); const int phys_ = __builtin_amdgcn_readfirstlane(pt[s * NPAGES + pg_]); \
        const size_t base_ = ((size_t)phys_ * PAGE + (size_t)((ci_) & 7) * 16) * DA + loff; \
        _Pragma("unroll") for (int i_ = 0; i_ < 8; ++i_) { Kn[i_] = __builtin_nontemporal_load((const GAS f32x4*)(ck + base_ + (size_t)i_ * 2 * DA)); \
                                                          Vn[i_] = __builtin_nontemporal_load((const GAS f32x4*)(cv + base_ + (size_t)i_ * 2 * DA)); } } while (0)
    DISSUE(0);
    for (int ci = 0; ci < NCH; ++ci) {
        f32x4 Kc[8], Vc[8];
#pragma unroll
        for (int i = 0; i < 8; ++i) { Kc[i] = Kn[i]; Vc[i] = Vn[i]; }
        if (ci + 1 < NCH) DISSUE(ci + 1);
        const int kpos0 = (page0 + (ci >> 3)) * PAGE + (ci & 7) * 16 + kk;
        float sc[8][DS];
#pragma unroll
        for (int i = 0; i < 8; ++i)
#pragma unroll
            for (int q = 0; q < DS; ++q) {
                float d = Kc[i].x * Qr[q].x; d = fmaf(Kc[i].y, Qr[q].y, d); d = fmaf(Kc[i].z, Qr[q].z, d); d = fmaf(Kc[i].w, Qr[q].w, d);
                d = row16_sum(d);
                sc[i][q] = fmaf(slope2, (float)(kpos0 + 2 * i - (PAST + q)), d);
            }
        float al[DS];
#pragma unroll
        for (int q = 0; q < DS; ++q) {
            float cm = sc[0][q];
#pragma unroll
            for (int i = 1; i < 8; ++i) cm = fmaxf(cm, sc[i][q]);
            cm = swap32_max(cm);
            const float mn = fmaxf(m[q], cm);
            al[q] = __builtin_amdgcn_exp2f(m[q] - mn); m[q] = mn;
            float ls = 0.f;
#pragma unroll
            for (int i = 0; i < 8; ++i) { sc[i][q] = __builtin_amdgcn_exp2f(sc[i][q] - mn); ls += sc[i][q]; }
            l[q] = fmaf(l[q], al[q], ls);
        }
#pragma unroll
        for (int q = 0; q < DS; ++q) { const float ao = other16(al[q], comp != 0); aown[q] = aown[q] * al[q]; aoth[q] = aoth[q] * ao; }
#pragma unroll
        for (int i = 0; i < 8; ++i)
#pragma unroll
            for (int q = 0; q < DS; ++q) { const float p = sc[i][q], po = other16(p, comp != 0);
                aown[q].x = fmaf(p, Vc[i].x, aown[q].x); aown[q].y = fmaf(p, Vc[i].y, aown[q].y); aown[q].z = fmaf(p, Vc[i].z, aown[q].z); aown[q].w = fmaf(p, Vc[i].w, aown[q].w);
                aoth[q].x = fmaf(po, Vc[i].x, aoth[q].x); aoth[q].y = fmaf(po, Vc[i].y, aoth[q].y); aoth[q].z = fmaf(po, Vc[i].z, aoth[q].z); aoth[q].w = fmaf(po, Vc[i].w, aoth[q].w); }
    }
#undef DISSUE
#pragma unroll
    for (int q = 0; q < DS; ++q) {
        l[q] = swap32_sum(l[q]);
        aown[q].x = swap32_sum(aown[q].x); aown[q].y = swap32_sum(aown[q].y); aown[q].z = swap32_sum(aown[q].z); aown[q].w = swap32_sum(aown[q].w);
        aoth[q].x = swap32_sum(aoth[q].x); aoth[q].y = swap32_sum(aoth[q].y); aoth[q].z = swap32_sum(aoth[q].z); aoth[q].w = swap32_sum(aoth[q].w);
    }
    if (kk == 0) {
#pragma unroll
        for (int q = 0; q < DS; ++q) {
            LAS float* ro = mrg + (size_t)((wave * 2 + comp) * DS + q) * MREC; LAS float* rx = mrg + (size_t)((wave * 2 + (comp ^ 1)) * DS + q) * MREC;
            *(LAS f32x4*)(ro + 8 + dl * 4) = aown[q]; *(LAS f32x4*)(rx + 8 + dl * 4) = aoth[q];
            if ((dl & 15) == 0) { ro[0] = m[q]; ro[1] = l[q]; }
        }
    }
    __syncthreads();
    {
        const int e = tid & 127;
#pragma unroll
        for (int t = 0; t < 2; ++t) {
            const int cq = (tid >> 7) + 4 * t;
            float M = -1e30f;
#pragma unroll
            for (int w = 0; w < NWAVES; ++w) M = fmaxf(M, mrg[(size_t)(w * 8 + cq) * MREC]);
            float L = 0.f, O = 0.f;
#pragma unroll
            for (int w = 0; w < NWAVES; ++w) { const LAS float* r = mrg + (size_t)(w * 8 + cq) * MREC; const float wt = __builtin_amdgcn_exp2f(r[0] - M); L = fmaf(wt, r[1], L); O = fmaf(wt, r[8 + e], O); }
            float* pr = part + ((size_t)((s * NH + h) * DSPLIT + split) * 8 + cq) * PREC;
            pr[4 + e] = O; if (e == 0) { pr[0] = M; pr[1] = L; }
        }
    }
    __syncthreads();
}

__device__ __forceinline__ void decode_finish(const float* __restrict__ QS, const float* __restrict__ KS, const float* __restrict__ VS, const float* __restrict__ part,
                                              const float* __restrict__ gsub, float lam, bf16* __restrict__ Y2, int s, int h, int q, int lane) {
    const float slope2 = alibi_slope2(h);
    float oc[2][2];
#pragma unroll
    for (int c = 0; c < 2; ++c) {
        float sn[DS];
        const float qv = QS[(size_t)(s * DS + q) * DA + h * 128 + c * 64 + lane];
#pragma unroll
        for (int j = 0; j < DS; ++j) { const float d = wave_sum(qv * KS[(size_t)(s * DS + j) * DA + h * 128 + c * 64 + lane]); sn[j] = (j <= q) ? fmaf(slope2, (float)(j - q), d) : -INFINITY; }
        float M = sn[0];
#pragma unroll
        for (int j = 1; j < DS; ++j) M = fmaxf(M, sn[j]);
        const float* pr[DSPLIT];
#pragma unroll
        for (int sp = 0; sp < DSPLIT; ++sp) { pr[sp] = part + ((size_t)((s * NH + h) * DSPLIT + sp) * 8 + c * DS + q) * PREC; M = fmaxf(M, pr[sp][0]); }
        float L = 0.f, o0 = 0.f, o1 = 0.f;
#pragma unroll
        for (int sp = 0; sp < DSPLIT; ++sp) { const float wt = __builtin_amdgcn_exp2f(pr[sp][0] - M); L = fmaf(wt, pr[sp][1], L); o0 = fmaf(wt, pr[sp][4 + 2 * lane], o0); o1 = fmaf(wt, pr[sp][4 + 2 * lane + 1], o1); }
#pragma unroll
        for (int j = 0; j < DS; ++j) { const float p = __builtin_amdgcn_exp2f(sn[j] - M); const float* vr = VS + (size_t)(s * DS + j) * DA + h * 128 + 2 * lane;
            L += p; o0 = fmaf(p, vr[0], o0); o1 = fmaf(p, vr[1], o1); }
        const float inv = 1.f / L;
        oc[c][0] = o0 * inv; oc[c][1] = o1 * inv;
    }
    const float a0 = oc[0][0] - lam * oc[1][0], a1 = oc[0][1] - lam * oc[1][1];
    const float r = (1.0f - LAM_INIT) / sqrtf(wave_sum(a0 * a0 + a1 * a1) * (1.f / 128.f) + EPS);
    *(GAS unsigned*)(Y2 + (size_t)(MP + s * DS + q) * DM + h * 128 + 2 * lane) = pk2(a0 * r * gsub[2 * lane], a1 * r * gsub[2 * lane + 1]);
}
}


struct Args { const float* in[27]; float* out; unsigned char* ws; int k_dm, k_ff, k_ple, pad; };
template <int LO, int HI>
__global__ void __launch_bounds__(NWAVES * 64, 2) mk_fwd(Args args) {
    extern __shared__ __attribute__((aligned(16))) unsigned char lds[];
    Frame F;
    F.lds = (LAS unsigned char*)lds;
    F.MISC = (volatile LAS unsigned*)(F.lds + MISC_OFF);
    F.tid = threadIdx.x; F.lane = F.tid & 63; F.wave = __builtin_amdgcn_readfirstlane(F.tid >> 6);
    F.G = gridDim.x; { const int bx = blockIdx.x; F.vcu = (F.G % 8 == 0) ? (bx % 8) * (F.G / 8) + bx / 8 : bx; }
    F.ctl = (gu32*)(args.ws + WS_CTL);

#define IN(k) (LO <= (k) && (k) < HI)
#define MYTID() (F.wave * 64 + lane_id_v())
#define KARGS() const __attribute__((address_space(4))) Args* ap = (const __attribute__((address_space(4))) Args*)__builtin_amdgcn_kernarg_segment_ptr(); asm volatile("" : "+s"(ap)); \
    unsigned char* const ws = ap->ws; float* const out = ap->out; (void)ws; (void)out
#define WSP(T, off) ((T*)(ws + (off)))
#define PHASE_LANE() int tl_ = MYTID(); asm volatile("" : "+v"(tl_)); const int ptid = tl_, plane = tl_ & 63; (void)ptid; (void)plane
#define SEAM(k) do { if constexpr (IN(k) && IN((k) + 1)) xcd_barrier(bar); } while (0)
    for (int u = F.tid; u < (LDS_BYTES - LDSCTL_OFF) / 4; u += NWAVES * 64) ((LAS unsigned*)(F.lds + LDSCTL_OFF))[u] = 0u;
    __syncthreads();
    XcdBarrier bar; bar.bar = (unsigned*)(F.ctl + CW_BAR); bar.x = 0; bar.st = nullptr; bar.wv = (unsigned)F.wave;
    if constexpr (HI - LO > 1) bar = xcd_barrier_post((unsigned*)(F.ctl + CW_BAR), F.MISC + 8, (unsigned)F.wave);
    const int gw = F.vcu * NWAVES + F.wave, NGW = F.G * NWAVES;

    if constexpr (IN(0)) {
        PHASE_LANE(); KARGS();
        const float* x_p = ap->in[0]; const float* x_s = ap->in[1]; const float* p_p = ap->in[6]; const float* p_s = ap->in[7]; const float* g_pre_mix = ap->in[19];
        bf16* XN = WSP(bf16, WS_XN); bf16* PEb = WSP(bf16, WS_PE);
        LAS float* scr = (LAS float*)(F.lds + RING_OFF + F.wave * 16384);
        constexpr int I_IN = (DM / 64) * (NIN / 32), I_OUT = (DM / 64) * (DM / 32), I_F1 = (DM / 64) * (DFF / 32), I_F2 = (DFF / 64) * (DM / 32), I_G = I_OUT, I_P = (DPLE / 64) * (DM / 32);
        constexpr int NITEMS = I_IN + I_OUT + I_F1 + I_F2 + I_G + I_P;
        for (int it = gw; it < NITEMS; it += NGW) {
            int r = it;
            if (r < I_IN) { const int nblk = NIN / 32, kb = r / nblk, nb = r % nblk; p0_transpose_item(ap->in[8], DM, NIN, WSP(bf16, WS_WIN), 64 * kb, 32 * nb, win_dest_row(32 * nb), scr, plane); continue; } r -= I_IN;
            if (r < I_OUT) { const int nblk = DM / 32, kb = r / nblk, nb = r % nblk; p0_transpose_item(ap->in[9], DM, DM, WSP(bf16, WS_WOUT), 64 * kb, 32 * nb, 32 * nb, scr, plane); continue; } r -= I_OUT;
            if (r < I_F1) { const int nblk = DFF / 32, kb = r / nblk, nb = r % nblk; p0_transpose_item(ap->in[23], DM, DFF, WSP(bf16, WS_WFF1), 64 * kb, 32 * nb, 32 * nb, scr, plane); continue; } r -= I_F1;
            if (r < I_F2) { const int nblk = DM / 32, kb = r / nblk, nb = r % nblk; p0_transpose_item(ap->in[24], DFF, DM, WSP(bf16, WS_WFF2), 64 * kb, 32 * nb, 32 * nb, scr, plane); continue; } r -= I_F2;
            if (r < I_G) { const int nblk = DM / 32, kb = r / nblk, nb = r % nblk; p0_transpose_item(ap->in[26], DM, DM, WSP(bf16, WS_WGATE), 64 * kb, 32 * nb, 32 * nb, scr, plane); continue; } r -= I_G;
            { const int nblk = DM / 32, kb = r / nblk, nb = r % nblk; p0_transpose_item(ap->in[25], DPLE, DM, WSP(bf16, WS_WPLE), 64 * kb, 32 * nb, 32 * nb, scr, plane); }
        }
        for (int m = gw; m < MR; m += NGW) {
            rms_row_to_bf16(x_row(x_p, x_s, m), g_pre_mix, XN + (size_t)m * DM, plane);
            cvt_row256(m < MP ? p_p + (size_t)m * DPLE : p_s + (size_t)(m - MP) * DPLE, PEb + (size_t)m * DPLE, plane);
        }
        for (int m = MR + gw; m < MT; m += NGW) {
            ((GAS unsigned long long*)(XN + (size_t)m * DM))[plane] = 0ull; ((GAS unsigned long long*)(XN + (size_t)m * DM))[64 + plane] = 0ull;
            ((GAS unsigned long long*)(XN + (size_t)m * DM))[128 + plane] = 0ull; ((GAS unsigned long long*)(XN + (size_t)m * DM))[192 + plane] = 0ull;
            ((GAS unsigned long long*)(PEb + (size_t)m * DPLE))[plane] = 0ull;
        }
    }
    SEAM(0);

    if constexpr (IN(1)) {
        KARGS();
        {
            pg8::Gemm g{WSP(bf16, WS_XN), WSP(bf16, WS_WIN), MT, NIN, ap->k_dm}; pg8::StaticOrder S; S.init(MT, NIN, F.G, (int)blockIdx.x);
            EpiIn E{WSP(bf16, WS_Q), WSP(bf16, WS_K), WSP(bf16, WS_V), WSP(bf16, WS_U), WSP(float, WS_QS), out};
            pg8::gemm_phase<EpiIn, pg8::StaticOrder, true, true>(F.lds + RING_OFF, g, S, E, MYTID());
        }
        {
            pg8::Gemm g{WSP(bf16, WS_PE), WSP(bf16, WS_WPLE), MT, DM, ap->k_ple}; pg8::StaticOrder S; S.init(MT, DM, F.G, (int)blockIdx.x);
            EpiB16<0> E{WSP(bf16, WS_E), DM};
            pg8::gemm_phase<EpiB16<0>, pg8::StaticOrder, true, true>(F.lds + RING_OFF, g, S, E, MYTID());
        }
    }
    SEAM(1);

    if constexpr (IN(2)) {
        PHASE_LANE(); KARGS();
        const float* lq1 = ap->in[10]; const float* lk1 = ap->in[11]; const float* lq2 = ap->in[12]; const float* lk2 = ap->in[13]; const float* g_subln = ap->in[14];
        bf16* Qb = WSP(bf16, WS_Q); bf16* Kb = WSP(bf16, WS_K); bf16* Vb = WSP(bf16, WS_V); bf16* Y2 = WSP(bf16, WS_Y2);
        const float lam = __builtin_bit_cast(float, __builtin_amdgcn_readfirstlane(__builtin_bit_cast(int, diff_lambda(lq1, lk1, lq2, lk2, plane))));
        for (int uu = F.vcu; uu < 512; uu += F.G) {
            const int v = uu & 255, second = uu >> 8;
            const int bh = v >> 3, sidx = v & 7, qb = second ? 15 - sidx : sidx;
            const int b = bh >> 2, h = bh & 3;
            const size_t row0 = (size_t)b * SEQ + (size_t)qb * 128;
            att::attn_unit(Qb + row0 * DA + h * 128, Kb + (size_t)b * SEQ * DA + h * 128, Vb + (size_t)b * SEQ * DA + h * 128,
                           Y2 + row0 * DM + h * 128, qb * 128, alibi_slope2(h), lam, g_subln, (char*)lds + RING_OFF, MYTID());
        }
    }
    if constexpr (IN(3)) {
        PHASE_LANE(); KARGS();
        const float* state_conv = ap->in[4]; const float* w_dw = ap->in[15]; const float* b_dw = ap->in[16]; const float* ln_g = ap->in[17]; const float* ln_b = ap->in[18];
        bf16* Ub = WSP(bf16, WS_U); bf16* Y2 = WSP(bf16, WS_Y2);
        LAS float* wl = (LAS float*)(F.lds + RING_OFF);
        for (int i = ptid; i < CONV_WROWS * DC / 4; i += NWAVES * 64) { const int r = i / (DC / 4) - 3;
            ((LAS f32x4*)wl)[i] = (r >= 0 && r < CW) ? ((const GAS f32x4*)w_dw)[i - 3 * (DC / 4)] : (f32x4){0.f, 0.f, 0.f, 0.f}; }
        __syncthreads();
        for (int cu = F.vcu; cu < 256 + 4; cu += F.G) {
            if (cu < 256) { const int b = cu >> 5, blk = cu & 31;
                for (int gi = 0; gi < 2; ++gi) conv_group<0>(Ub, nullptr, nullptr, wl, b_dw, ln_g, ln_b, Y2, b, blk * 64 + F.wave * 8 + gi * 4, plane); }
            else { const int s = (cu - 256) * 8 + F.wave; conv_group<1>(Ub, state_conv, out + O_CS, wl, b_dw, ln_g, ln_b, Y2, s, 0, plane); }
        }
        __syncthreads();
    }
    if constexpr (IN(4)) {
        KARGS();
        const float* cache_k = ap->in[2]; const float* cache_v = ap->in[3]; const int* page_table = (const int*)ap->in[5]; float* QS = WSP(float, WS_QS); float* DP = WSP(float, WS_DP);
        for (int du = F.vcu; du < DB * NH * DSPLIT; du += F.G) {
            const int s = du >> 3, h = (du >> 1) & 3, sp = du & 1;
            dec::decode_unit(QS, cache_k, cache_v, page_table, DP, s, h, sp, (LAS float*)(F.lds + RING_OFF), MYTID());
        }
    }
    SEAM(4);

    if constexpr (IN(5)) {
        PHASE_LANE(); KARGS();
        const float* lq1 = ap->in[10]; const float* lk1 = ap->in[11]; const float* lq2 = ap->in[12]; const float* lk2 = ap->in[13]; const float* g_subln = ap->in[14];
        float* QS = WSP(float, WS_QS); float* DP = WSP(float, WS_DP); bf16* Y2 = WSP(bf16, WS_Y2);
        const float lam = diff_lambda(lq1, lk1, lq2, lk2, plane);
        for (int t = gw; t < DB * NH * DS; t += NGW) { const int s = t >> 4, h = (t >> 2) & 3, q = t & 3;
            dec::decode_finish(QS, out + O_KS, out + O_VS, DP, g_subln, lam, Y2, s, h, q, plane); }
    }
    SEAM(5);

    if constexpr (IN(6)) {
        KARGS();
        pg8::Gemm g{WSP(bf16, WS_Y2), WSP(bf16, WS_WOUT), MT, DM, ap->k_dm}; pg8::StaticOrder S; S.init(MT, DM, F.G, (int)blockIdx.x);
        EpiF32 E{WSP(float, WS_MM), DM};
        pg8::gemm_phase<EpiF32, pg8::StaticOrder, true, true>(F.lds + RING_OFF, g, S, E, MYTID());
    }
    SEAM(6);
    if constexpr (IN(7)) {
        PHASE_LANE(); KARGS();
        const float* x_p = ap->in[0]; const float* x_s = ap->in[1]; const float* g_post_mix = ap->in[20]; const float* g_pre_ffn = ap->in[21];
        float* MM = WSP(float, WS_MM); float* Hf = WSP(float, WS_H); bf16* HN = WSP(bf16, WS_HN);
        for (int m = gw; m < MR; m += NGW) post_mix_row(MM + (size_t)m * DM, x_row(x_p, x_s, m), g_post_mix, g_pre_ffn, Hf + (size_t)m * DM, HN + (size_t)m * DM, plane);
    }
    SEAM(7);
    if constexpr (IN(8)) {
        KARGS();
        pg8::Gemm g{WSP(bf16, WS_HN), WSP(bf16, WS_WFF1), MT, DFF, ap->k_dm}; pg8::StaticOrder S; S.init(MT, DFF, F.G, (int)blockIdx.x);
        EpiB16<1> E{WSP(bf16, WS_HH), DFF};
        pg8::gemm_phase<EpiB16<1>, pg8::StaticOrder, true, true>(F.lds + RING_OFF, g, S, E, MYTID());
    }
    SEAM(8);
    if constexpr (IN(9)) {
        KARGS();
        pg8::Gemm g{WSP(bf16, WS_HH), WSP(bf16, WS_WFF2), MT, DM, ap->k_ff}; pg8::StaticOrder S; S.init(MT, DM, F.G, (int)blockIdx.x);
        EpiF32 E{WSP(float, WS_FF), DM};
        pg8::gemm_phase<EpiF32, pg8::StaticOrder, true, true>(F.lds + RING_OFF, g, S, E, MYTID());
    }
    SEAM(9);
    if constexpr (IN(10)) {
        PHASE_LANE(); KARGS();
        const float* g_post_ffn = ap->in[22];
        float* FFo = WSP(float, WS_FF); float* Hf = WSP(float, WS_H); float* H2 = WSP(float, WS_H2); bf16* H2B = WSP(bf16, WS_H2B);
        for (int m = gw; m < MR; m += NGW) post_ffn_row(FFo + (size_t)m * DM, Hf + (size_t)m * DM, g_post_ffn, H2 + (size_t)m * DM, H2B + (size_t)m * DM, plane);
    }
    SEAM(10);
    if constexpr (IN(11)) {
        KARGS();
        pg8::Gemm g{WSP(bf16, WS_H2B), WSP(bf16, WS_WGATE), MT, DM, ap->k_dm}; pg8::StaticOrder S; S.init(MT, DM, F.G, (int)blockIdx.x);
        EpiGate E{WSP(float, WS_H2), WSP(bf16, WS_E), out};
        pg8::gemm_phase<EpiGate, pg8::StaticOrder, true, true>(F.lds + RING_OFF, g, S, E, MYTID());
    }
#undef IN
#undef SEAM
}

#ifndef MK_N_LAUNCHES
#define MK_N_LAUNCHES 1
#endif
constexpr int NPH = 12;
template <int LO, int HI> static bool launch_range(int grid, const Args& a, hipStream_t stream) {
    static bool attr_set = false;
    if (!attr_set) { if (hipFuncSetAttribute((const void*)mk_fwd<LO, HI>, hipFuncAttributeMaxDynamicSharedMemorySize, LDS_BYTES) != hipSuccess) { fprintf(stderr, "kernel_launch: hipFuncSetAttribute failed\n"); return false; } attr_set = true; }
    hipLaunchKernelGGL((mk_fwd<LO, HI>), dim3(grid), dim3(NWAVES * 64), LDS_BYTES, stream, a);
    const hipError_t le = hipPeekAtLastError();
    if (le != hipSuccess) { fprintf(stderr, "kernel_launch: launch [%d,%d) failed: %s\n", LO, HI, hipGetErrorName(le)); return false; }
    return true;
}
extern "C" void kernel_launch(void* const* d_in, const int* in_sizes, int n_in, void* d_out, int out_size, void* d_ws, size_t ws_size, hipStream_t stream) {
    static int grid = 0;
    if (grid == 0) {
        if (n_in != 27 || in_sizes[0] != MP * DM || out_size != (int)O_END || ws_size < WS_END) {
            fprintf(stderr, "kernel_launch: unexpected problem shape: n_in %d in0 %d out %d ws %zu (need %zu)\n", n_in, n_in > 0 ? in_sizes[0] : -1, out_size, ws_size, (size_t)WS_END); grid = -1; return; }
        int dev = 0, cus = 0;
        if (hipGetDevice(&dev) != hipSuccess || hipDeviceGetAttribute(&cus, hipDeviceAttributeMultiprocessorCount, dev) != hipSuccess) { fprintf(stderr, "kernel_launch: device query failed\n"); grid = -1; return; }
        grid = cus;
    }
    if (grid < 0) return;
    if (hipMemsetAsync((char*)d_ws + WS_CTL, 0, CTL_ZERO_BYTES, stream) != hipSuccess) { fprintf(stderr, "kernel_launch: memset failed\n"); return; }
    Args a{};
    for (int i = 0; i < 27; ++i) a.in[i] = (const float*)d_in[i];
    a.out = (float*)d_out; a.ws = (unsigned char*)d_ws; a.k_dm = DM; a.k_ff = DFF; a.k_ple = DPLE; a.pad = 0;
#if MK_N_LAUNCHES == 1
    launch_range<0, 12>(grid, a, stream);
#else
    launch_range<0, 1>(grid, a, stream) && launch_range<1, 2>(grid, a, stream) && launch_range<2, 3>(grid, a, stream) && launch_range<3, 4>(grid, a, stream) &&
    launch_range<4, 5>(grid, a, stream) && launch_range<5, 6>(grid, a, stream) && launch_range<6, 7>(grid, a, stream) && launch_range<7, 8>(grid, a, stream) &&
    launch_range<8, 9>(grid, a, stream) && launch_range<9, 10>(grid, a, stream) && launch_range<10, 11>(grid, a, stream) && launch_range<11, 12>(grid, a, stream);
#endif
}
```

```cpp
#include <hip/hip_runtime.h>
#include <cstdio>
#include <cstdint>
#include <cmath>

namespace pg8 {
#define PG8_LAS __attribute__((address_space(3)))
typedef unsigned short bf16_t;
typedef short bf16x8 __attribute__((ext_vector_type(8)));
typedef float f32x4 __attribute__((ext_vector_type(4)));
typedef unsigned u32x4 __attribute__((ext_vector_type(4)));
constexpr int BM = 256, BK = 64, HALF = 128, HTB = HALF * BK * 2  , STAGE_BYTES = 8 * HTB, NXCD = 8, WGM = 8;

__host__ __device__ __forceinline__ int lds_byte(int r, int c) { const int st = (r >> 4) * 2 + (c >> 5), rr = r & 15, cc = c & 31, ob = rr * 64 + cc * 2; return st * 1024 + (ob ^ (((ob >> 9) & 1) << 5)); }
__host__ __device__ __forceinline__ void stage_rc(int b, int& R, int& C) { const int st = b / 1024, sb = b % 1024, swz = sb ^ (((sb >> 9) & 1) << 5); R = (st >> 1) * 16 + swz / 64; C = (st & 1) * 32 + (swz % 64) / 2; }
__host__ __device__ __forceinline__ int perm32(int rho) { const int n = rho >> 4, i = rho & 15; return 8 * (i >> 2) + 4 * n + (i & 3); }

struct Unit { int pm, pn; };
struct Gemm { const bf16_t* A; const bf16_t* Bt; int M, N, K; };

struct StaticOrder {
    int nM, nN, nwg, G, c;
    __host__ __device__ void init(int M, int N, int G_, int c_) { nM = M / BM; nN = N / BM; nwg = nM * nN; G = G_; c = c_; }
    __host__ __device__ bool next(int i, Unit& u) const {
        const long L = (long)i * G + c; if (L >= nwg) return false;
        int wgid = (int)L; { const int q = nwg / NXCD, r = nwg % NXCD, xcd = wgid % NXCD, off = wgid / NXCD; wgid = (xcd < r ? xcd * (q + 1) : r * (q + 1) + (xcd - r) * q) + off; }
        const int nig = WGM * nN, gid = wgid / nig, fm = gid * WGM, gsz = (nM - fm) < WGM ? (nM - fm) : WGM;
        u.pm = fm + ((wgid % nig) % gsz); u.pn = (wgid % nig) / gsz; return true;
    }
    __device__ __forceinline__ void a_ready(const Unit&) const {}
    __device__ __forceinline__ void done(const Unit&) const {}
};


__device__ __forceinline__ unsigned cvt_pk_bf16(float lo, float hi) { unsigned r; asm volatile("v_cvt_pk_bf16_f32 %0, %1, %2" : "=v"(r) : "v"(lo), "v"(hi)); return r; }
typedef float f32x2 __attribute__((ext_vector_type(2)));

template <class Epi, class Sched, bool ALIGN_EPI = false, bool SP2 = false>
__device__ __forceinline__ void gemm_phase(PG8_LAS unsigned char* lds, const Gemm g, const Sched& S, const Epi& E, int tid_in) {
    int tid_ = tid_in; asm volatile("" : "+v"(tid_));
    const int tid = tid_, wid = __builtin_amdgcn_readfirstlane(tid >> 6), lane = tid & 63, wr = wid >> 2, wc = wid & 3, fr = lane & 15, fq = lane >> 4;
    const int K = g.K, nt = K / BK;
    unsigned voffA[2], voffB[2];
#pragma unroll
    for (int i = 0; i < 2; ++i) { int R, C; stage_rc(tid * 16 + i * 8192, R, C); const int Rb = Epi::PERM ? ((R & ~31) + perm32(R & 31)) : R;
        voffA[i] = (unsigned)(R * K + C) * 2u; voffB[i] = (unsigned)(Rb * K + C) * 2u; }
    const size_t kstep = (size_t)(BK * 2);
    const size_t hstep = (size_t)HALF * K * 2;
    const size_t tstep = 2 * hstep;
    const unsigned ldsw = (unsigned)wid * 1024u;
    const int aoff = lds_byte(wr * 64 + fr, fq * 8), boff = lds_byte(wc * 32 + fr, fq * 8);
#define PG8_SA(b, h) (((b) * 2 + (h)) * HTB)
#define PG8_SB(b, h) ((4 + (b) * 2 + (h)) * HTB)
#define PG8_STAGE(bufoff, gbase, voff) do { _Pragma("unroll") for (int _i = 0; _i < 2; ++_i) \
        __builtin_amdgcn_global_load_lds((const unsigned*)((const char*)(gbase) + (voff)[_i]), (PG8_LAS unsigned*)(lds + (bufoff) + ldsw + _i * 8192), 16, 0, 0); } while (0)
#define PG8_LDA(dst, b, h) do { _Pragma("unroll") for (int m = 0; m < 4; ++m) _Pragma("unroll") for (int k = 0; k < 2; ++k) dst[m][k] = *(const PG8_LAS bf16x8*)(lds + PG8_SA(b, h) + aoff + m * 2048 + k * 1024); } while (0)
#define PG8_LDB(dst, b, h) do { _Pragma("unroll") for (int n = 0; n < 2; ++n) _Pragma("unroll") for (int k = 0; k < 2; ++k) dst[n][k] = *(const PG8_LAS bf16x8*)(lds + PG8_SB(b, h) + boff + n * 2048 + k * 1024); } while (0)
#define PG8_MMA(ai, bj, At, Bt) do { __builtin_amdgcn_s_setprio(1); _Pragma("unroll") for (int m = 0; m < 4; ++m) _Pragma("unroll") for (int n = 0; n < 2; ++n) _Pragma("unroll") for (int k = 0; k < 2; ++k) \
        acc[ai][bj][m][n] = __builtin_amdgcn_mfma_f32_16x16x32_bf16(Bt[n][k], At[m][k], acc[ai][bj][m][n], 0, 0, 0); __builtin_amdgcn_s_setprio(0); } while (0)
#define PG8_WAIT_V(n) asm volatile("s_waitcnt vmcnt(" #n ")" ::: "memory")
#define PG8_WAIT_L(n) asm volatile("s_waitcnt lgkmcnt(" #n ")" ::: "memory")
#define PG8_BAR __builtin_amdgcn_s_barrier()
#define PG8_SCHED __builtin_amdgcn_sched_barrier(0)
    Unit cur, nxt; int ui = 0;
    if (!S.next(0, cur)) return;
    f32x4 acc[2][2][4][2];
#pragma unroll
    for (int a = 0; a < 2; ++a)
#pragma unroll
        for (int b = 0; b < 2; ++b)
#pragma unroll
            for (int m = 0; m < 4; ++m)
#pragma unroll
                for (int n = 0; n < 2; ++n) acc[a][b][m][n] = (f32x4){0.f, 0.f, 0.f, 0.f};
    bf16x8 At[4][2], B0[2][2], B1[2][2];
    const char* cA = (const char*)g.A + (size_t)cur.pm * tstep; const char* cB = (const char*)g.Bt + (size_t)cur.pn * tstep;
    S.a_ready(cur);
    if constexpr (SP2) {
        PG8_STAGE(PG8_SB(0, 0), cB, voffB); PG8_STAGE(PG8_SB(0, 1), cB + hstep, voffB); PG8_STAGE(PG8_SA(0, 0), cA, voffA); PG8_STAGE(PG8_SA(0, 1), cA + hstep, voffA);
        if (wr == 1) PG8_BAR;
        PG8_WAIT_V(2); PG8_BAR;
        PG8_STAGE(PG8_SB(1, 0), cB + kstep, voffB); PG8_STAGE(PG8_SA(1, 0), cA + kstep, voffA); PG8_STAGE(PG8_SB(1, 1), cB + hstep + kstep, voffB);
        PG8_WAIT_V(6); PG8_BAR;
    } else {
        PG8_STAGE(PG8_SB(0, 0), cB, voffB); PG8_STAGE(PG8_SA(0, 0), cA, voffA); PG8_STAGE(PG8_SB(0, 1), cB + hstep, voffB); PG8_STAGE(PG8_SA(0, 1), cA + hstep, voffA);
        if (wr == 1) PG8_BAR;
        PG8_WAIT_V(4); PG8_BAR;
        PG8_STAGE(PG8_SB(1, 0), cB + kstep, voffB); PG8_STAGE(PG8_SA(1, 0), cA + kstep, voffA); PG8_STAGE(PG8_SB(1, 1), cB + hstep + kstep, voffB);
        PG8_WAIT_V(6); PG8_BAR;
    }
    for (;;) {
        const bool has_next = S.next(ui + 1, nxt);
        const char* nA = has_next ? (const char*)g.A + (size_t)nxt.pm * tstep : cA; const char* nB = has_next ? (const char*)g.Bt + (size_t)nxt.pn * tstep : cB;
        for (int t = 0; t < nt; t += 2) {
            const bool last = (t == nt - 2);
            const char* a1 = cA + (size_t)(t + 1) * kstep;
            const char* a2 = last ? nA : cA + (size_t)(t + 2) * kstep; const char* b2 = last ? nB : cB + (size_t)(t + 2) * kstep;
            const char* a3 = a2 + kstep; const char* b3 = b2 + kstep;
            if (last && has_next) S.a_ready(nxt);
            if constexpr (SP2) {
            PG8_LDB(B0, 0, 0); PG8_LDB(B1, 0, 1); PG8_SCHED; PG8_LDA(At, 0, 0); PG8_STAGE(PG8_SA(1, 1), a1 + hstep, voffA);
            PG8_WAIT_V(8); PG8_WAIT_L(0); PG8_BAR; PG8_MMA(0, 0, At, B0); PG8_MMA(0, 1, At, B1); PG8_BAR; PG8_SCHED;
            PG8_LDA(At, 0, 1); PG8_STAGE(PG8_SB(0, 0), b2, voffB); PG8_STAGE(PG8_SB(0, 1), b2 + hstep, voffB); PG8_STAGE(PG8_SA(0, 0), a2, voffA);
            PG8_WAIT_V(8); PG8_WAIT_L(0); PG8_BAR; PG8_MMA(1, 0, At, B0); PG8_MMA(1, 1, At, B1); PG8_BAR; PG8_SCHED;
            PG8_LDB(B0, 1, 0); PG8_LDB(B1, 1, 1); PG8_SCHED; PG8_LDA(At, 1, 0); PG8_STAGE(PG8_SA(0, 1), a2 + hstep, voffA);
            PG8_WAIT_V(8); PG8_WAIT_L(0); PG8_BAR; PG8_MMA(0, 0, At, B0); PG8_MMA(0, 1, At, B1); PG8_BAR; PG8_SCHED;
            PG8_LDA(At, 1, 1); PG8_STAGE(PG8_SB(1, 0), b3, voffB); PG8_STAGE(PG8_SB(1, 1), b3 + hstep, voffB); PG8_STAGE(PG8_SA(1, 0), a3, voffA);
            PG8_WAIT_V(8); PG8_WAIT_L(0); PG8_BAR; PG8_MMA(1, 0, At, B0); PG8_MMA(1, 1, At, B1); PG8_BAR; PG8_SCHED;
            } else {
            PG8_LDB(B0, 0, 0); PG8_SCHED; PG8_LDA(At, 0, 0); PG8_STAGE(PG8_SA(1, 1), a1 + hstep, voffA);
            PG8_WAIT_L(8); PG8_BAR; PG8_WAIT_L(0); PG8_MMA(0, 0, At, B0); PG8_BAR; PG8_SCHED;
            PG8_LDB(B1, 0, 1); PG8_STAGE(PG8_SB(0, 0), b2, voffB);
            PG8_BAR; PG8_WAIT_L(0); PG8_MMA(0, 1, At, B1); PG8_BAR;
            PG8_LDA(At, 0, 1); PG8_STAGE(PG8_SA(0, 0), a2, voffA);
            PG8_BAR; PG8_WAIT_L(0); PG8_MMA(1, 0, At, B0); PG8_BAR; PG8_SCHED;
            PG8_STAGE(PG8_SB(0, 1), b2 + hstep, voffB);
            PG8_WAIT_V(6); PG8_BAR; PG8_MMA(1, 1, At, B1); PG8_BAR;
            PG8_LDB(B0, 1, 0); PG8_SCHED; PG8_LDA(At, 1, 0); PG8_STAGE(PG8_SA(0, 1), a2 + hstep, voffA);
            PG8_WAIT_L(8); PG8_BAR; PG8_WAIT_L(0); PG8_MMA(0, 0, At, B0); PG8_BAR; PG8_SCHED;
            PG8_LDB(B1, 1, 1); PG8_STAGE(PG8_SB(1, 0), b3, voffB);
            PG8_BAR; PG8_WAIT_L(0); PG8_MMA(0, 1, At, B1); PG8_BAR;
            PG8_LDA(At, 1, 1); PG8_STAGE(PG8_SA(1, 0), a3, voffA);
            PG8_BAR; PG8_WAIT_L(0); PG8_MMA(1, 0, At, B0); PG8_BAR; PG8_SCHED;
            PG8_STAGE(PG8_SB(1, 1), b3 + hstep, voffB);
            PG8_WAIT_V(6); PG8_BAR; PG8_MMA(1, 1, At, B1); PG8_BAR;
            }
        }
        if constexpr (ALIGN_EPI) { if (wr == 0) PG8_BAR; }
        if constexpr (!Epi::AFTER_DRAIN) { E(acc, cur, wr, wc, fr, fq); S.done(cur); }
        if (!has_next) break;
#pragma unroll
        for (int a = 0; a < 2; ++a)
#pragma unroll
            for (int b = 0; b < 2; ++b)
#pragma unroll
                for (int m = 0; m < 4; ++m)
#pragma unroll
                    for (int n = 0; n < 2; ++n) acc[a][b][m][n] = (f32x4){0.f, 0.f, 0.f, 0.f};
        cur = nxt; cA = nA; cB = nB; ++ui;
        if constexpr (ALIGN_EPI) { if (wr == 1) PG8_BAR; }
    }
    PG8_WAIT_V(0);
    if constexpr (!ALIGN_EPI) { if (wr == 0) PG8_BAR; }
    PG8_BAR;
    if constexpr (Epi::AFTER_DRAIN) { E.fused(acc, cur, wr, wc, fr, fq, lds, wid, lane); S.done(cur); }
#undef PG8_SA
#undef PG8_SB
#undef PG8_STAGE
#undef PG8_LDA
#undef PG8_LDB
#undef PG8_MMA
#undef PG8_WAIT_V
#undef PG8_WAIT_L
#undef PG8_BAR
#undef PG8_SCHED
}
}

#define GAS __attribute__((address_space(1)))
#define LAS __attribute__((address_space(3)))
typedef unsigned short bf16;
typedef unsigned v4u __attribute__((ext_vector_type(4)));
typedef float f32x4 __attribute__((ext_vector_type(4)));
typedef short bf16x8 __attribute__((ext_vector_type(8)));
typedef GAS unsigned gu32;
typedef GAS unsigned long long gu64;
#define RLX_AGENT __ATOMIC_RELAXED, __HIP_MEMORY_SCOPE_AGENT
#define LDS_WAIT() asm volatile("s_waitcnt lgkmcnt(0)" ::: "memory")
#define VM_WAIT() asm volatile("s_waitcnt vmcnt(0)" ::: "memory")
__device__ __forceinline__ unsigned long long rt() { return __builtin_amdgcn_s_memrealtime(); }
__device__ __forceinline__ unsigned f2bf(float f) { unsigned u = __builtin_bit_cast(unsigned, f); return (u + 0x7fffu + ((u >> 16) & 1u)) >> 16; }
__device__ __forceinline__ unsigned pk2(float lo, float hi) { return f2bf(lo) | (f2bf(hi) << 16); }

__device__ __forceinline__ int lane_id_v() { int l; asm volatile("v_mbcnt_lo_u32_b32 %0, -1, 0\n\tv_mbcnt_hi_u32_b32 %0, -1, %0" : "=v"(l)); return l; }

template <int CTRL> __device__ __forceinline__ float dppf(float x) { return __builtin_bit_cast(float, __builtin_amdgcn_mov_dpp(__builtin_bit_cast(int, x), CTRL, 0xf, 0xf, true)); }
constexpr int DPP_XOR1 = 0xB1, DPP_XOR2 = 0x4E, DPP_XOR7 = 0x141, DPP_XOR8 = 0x128;
__device__ __forceinline__ float row16_sum(float x) { x += dppf<DPP_XOR1>(x); x += dppf<DPP_XOR2>(x); x += dppf<DPP_XOR7>(x); x += dppf<DPP_XOR8>(x); return x; }
__device__ __forceinline__ float swap16_sum(float x) { auto s = __builtin_amdgcn_permlane16_swap(__float_as_uint(x), __float_as_uint(x), false, false); return __uint_as_float(s[0]) + __uint_as_float(s[1]); }
__device__ __forceinline__ float swap32_sum(float x) { auto s = __builtin_amdgcn_permlane32_swap(__float_as_uint(x), __float_as_uint(x), false, false); return __uint_as_float(s[0]) + __uint_as_float(s[1]); }
__device__ __forceinline__ float swap32_max(float x) { auto s = __builtin_amdgcn_permlane32_swap(__float_as_uint(x), __float_as_uint(x), false, false); return fmaxf(__uint_as_float(s[0]), __uint_as_float(s[1])); }
__device__ __forceinline__ float other16(float x, bool odd_row) { auto s = __builtin_amdgcn_permlane16_swap(__float_as_uint(x), __float_as_uint(x), false, false); return __uint_as_float(odd_row ? s[0] : s[1]); }

#define XB_TMO      128
#define XB_XCNT(j)  (256  + 64 * (j))
#define XB_XSUB(j)  (1280 + 64 * (j))
#define XB_XGEN(j)  (2304 + 64 * (j))
#define XB_TOP      3328
#define XB_TOPGEN   3392
#define XCD_BAR_WORDS 3456
#define XB_SPIN_CAP (1u << 18)

__device__ __forceinline__ unsigned xb_ld(unsigned* p)              { return __hip_atomic_load(p, __ATOMIC_RELAXED, __HIP_MEMORY_SCOPE_AGENT); }
__device__ __forceinline__ unsigned xb_add(unsigned* p, unsigned v) { return __hip_atomic_fetch_add(p, v, __ATOMIC_RELAXED, __HIP_MEMORY_SCOPE_AGENT); }
__device__ __forceinline__ unsigned xb_xcc_id() { return (unsigned)__builtin_amdgcn_s_getreg((3 << 11) | 20) & 0xFu; }
#define XB_SPIN(cond, bar) do { unsigned _sp = 0; while (cond) { __builtin_amdgcn_s_sleep(1); \
    if ((++_sp & 255u) == 0u) { if (xb_ld(&(bar)[XB_TMO])) break; if (_sp > XB_SPIN_CAP) { atomicAdd(&(bar)[XB_TMO], 1u); break; } } } } while (0)

struct XcdBarrier {
    unsigned* bar; unsigned x; unsigned wv;
    volatile LAS unsigned* st;
};

#define XB_IS_T0(b) ((b).wv == 0u && lane_id_v() == 0)
__device__ __forceinline__ XcdBarrier xcd_barrier_post(unsigned* bar, volatile LAS unsigned* st, unsigned wv) {
    XcdBarrier b; b.bar = bar; b.x = xb_xcc_id(); b.st = st; b.wv = wv;
    if (XB_IS_T0(b)) (void)xb_add(&bar[XB_XCNT(b.x)], 1u);
    return b;
}
__device__ __forceinline__ void xcd_barrier_complete(unsigned* bar, unsigned x, unsigned& nloc, unsigned& nx) {
    const unsigned G = gridDim.x * gridDim.y * gridDim.z;
    unsigned sum, cnt, mine, sp = 0u;
    for (;;) {
        sum = 0u; cnt = 0u; mine = 0u;
#pragma unroll
        for (unsigned j = 0; j < 16; ++j) { const unsigned c = xb_ld(&bar[XB_XCNT(j)]); sum += c; cnt += (c > 0u) ? 1u : 0u; mine = (j == x) ? c : mine; }
        if (sum == G) break;
        __builtin_amdgcn_s_sleep(1);
        if ((++sp & 255u) == 0u) { if (xb_ld(&bar[XB_TMO])) break; if (sp > XB_SPIN_CAP) { atomicAdd(&bar[XB_TMO], 1u); break; } }
    }
    nloc = mine > 0u ? mine : 1u; nx = cnt > 0u ? cnt : 1u;
}

__device__ __forceinline__ void xcd_barrier(const XcdBarrier& b) {
    asm volatile("s_waitcnt vmcnt(0)" ::: "memory");
    __syncthreads();
    if (XB_IS_T0(b)) {
        unsigned* bar = b.bar;
        __builtin_amdgcn_s_waitcnt(0);
        unsigned nloc = b.st[0], nx = b.st[1];
        if (nloc == 0u) { xcd_barrier_complete(bar, b.x, nloc, nx); b.st[0] = nloc; b.st[1] = nx; }
        const unsigned old = xb_add(&bar[XB_XSUB(b.x)], 1u);
        const unsigned gen = old / nloc;
        if (old + 1u == (gen + 1u) * nloc) {
            __builtin_amdgcn_fence(__ATOMIC_RELEASE, "agent");
            asm volatile("s_waitcnt vmcnt(0)" ::: "memory");
            const unsigned og = xb_add(&bar[XB_TOP], 1u);
            const unsigned tg = og / nx;
            if (og + 1u == (tg + 1u) * nx) xb_add(&bar[XB_TOPGEN], 1u);
            else XB_SPIN(xb_ld(&bar[XB_TOPGEN]) == tg, bar);
            __builtin_amdgcn_fence(__ATOMIC_ACQUIRE, "agent");
            xb_add(&bar[XB_XGEN(b.x)], 1u);
            asm volatile("s_waitcnt vmcnt(0)" ::: "memory");
        } else {
            XB_SPIN(xb_ld(&bar[XB_XGEN(b.x)]) == gen, bar);
            __builtin_amdgcn_fence(__ATOMIC_ACQUIRE, "agent");
            asm volatile("s_waitcnt vmcnt(0)" ::: "memory");
        }
    }
    __syncthreads();
}


constexpr int NWAVES = 8;
constexpr int DM = 1024, NB = 8, SEQ = 2048, DB = 32, DS = 4, PAST = 8192, PAGE = 128, NPAGES = 64;
constexpr int DA = 512, DC = 512, NH = 4, HD = 64, VD = 128, CW = 31, DFF = 4096, DPLE = 256, NIN = 2560;
constexpr int MP = NB * SEQ;
constexpr int MS = DB * DS;
constexpr int MR = MP + MS;
constexpr int MT = 16640;
constexpr float EPS = 1e-6f;
constexpr float LOG2E = 1.4426950408889634f;
constexpr float C2 = 0.125f * LOG2E;
constexpr float LAM_INIT = 0.2f;
constexpr size_t O_YP = 0, O_YS = O_YP + (size_t)MP * DM, O_KP = O_YS + (size_t)MS * DM, O_VP = O_KP + (size_t)MP * DA,
                 O_CP = O_VP + (size_t)MP * DA, O_KS = O_CP + (size_t)NB * 30 * DC, O_VS = O_KS + (size_t)MS * DA, O_CS = O_VS + (size_t)MS * DA,
                 O_END = O_CS + (size_t)DB * 30 * DC;
static_assert(O_END == 34430976, "output size");
constexpr size_t MiB = 1u << 20;
constexpr size_t al1(size_t x) { return (x + MiB - 1) / MiB * MiB; }
constexpr size_t WS_CTL = 0, CTL_ZERO_BYTES = 1 * MiB;
constexpr size_t WS_WIN = 1 * MiB;
constexpr size_t WS_WOUT = WS_WIN + al1((size_t)NIN * DM * 2);
constexpr size_t WS_WFF1 = WS_WOUT + al1((size_t)DM * DM * 2);
constexpr size_t WS_WFF2 = WS_WFF1 + al1((size_t)DFF * DM * 2);
constexpr size_t WS_WGATE = WS_WFF2 + al1((size_t)DFF * DM * 2);
constexpr size_t WS_WPLE = WS_WGATE + al1((size_t)DM * DM * 2);
constexpr size_t WS_XN = WS_WPLE + al1((size_t)DM * DPLE * 2);
constexpr size_t WS_Q = WS_XN + al1((size_t)MT * DM * 2);
constexpr size_t WS_K = WS_Q + al1((size_t)MT * DA * 2);
constexpr size_t WS_V = WS_K + al1((size_t)MT * DA * 2);
constexpr size_t WS_U = WS_V + al1((size_t)MT * DA * 2);
constexpr size_t WS_Y2 = WS_U + al1((size_t)MT * DC * 2);
constexpr size_t WS_MM = WS_Y2 + al1((size_t)MT * DM * 2);
constexpr size_t WS_H = WS_MM + al1((size_t)MT * DM * 4);
constexpr size_t WS_HN = WS_H + al1((size_t)MT * DM * 4);
constexpr size_t WS_HH = WS_HN + al1((size_t)MT * DM * 2);
constexpr size_t WS_FF = WS_HH + al1((size_t)MT * DFF * 2);
constexpr size_t WS_H2 = WS_FF + al1((size_t)MT * DM * 4);
constexpr size_t WS_H2B = WS_H2 + al1((size_t)MT * DM * 4);
constexpr size_t WS_PE = WS_H2B + al1((size_t)MT * DM * 2);
constexpr size_t WS_E = WS_PE + al1((size_t)MT * DPLE * 2);
constexpr size_t WS_QS = WS_E + al1((size_t)MT * DM * 2);
constexpr int DSPLIT = 2, PREC = 132;
constexpr size_t WS_DP = WS_QS + al1((size_t)MS * DA * 4);
constexpr int FF2_KSPLIT = 4;
constexpr size_t WS_FFP = WS_DP + al1((size_t)DB * NH * DSPLIT * 2 * DS * PREC * 4);
constexpr size_t WS_END = WS_FFP + al1((size_t)FF2_KSPLIT * MS * DM * 4);
constexpr int CW_TMO = 0, CW_CODE = 1, CW_BAR = 4096;

constexpr int RING_OFF = 0, RING_BYTES = 131072;
constexpr int LDSCTL_OFF = RING_BYTES, MISC_OFF = LDSCTL_OFF + 320;
constexpr int LDS_BYTES = 147456;
static_assert(MISC_OFF + 128 <= LDS_BYTES, "LDS map");


__device__ __forceinline__ float sigmoidf_fast(float x) { return __builtin_amdgcn_rcpf(1.0f + __builtin_amdgcn_exp2f(-x * LOG2E)); }
__device__ __forceinline__ v4u pack8(const f32x4& a, const f32x4& b) { v4u w; w.x = pg8::cvt_pk_bf16(a[0], a[1]); w.y = pg8::cvt_pk_bf16(a[2], a[3]); w.z = pg8::cvt_pk_bf16(b[0], b[1]); w.w = pg8::cvt_pk_bf16(b[2], b[3]); return w; }

struct EpiIn {
    static constexpr bool PERM = true, AFTER_DRAIN = false;
    bf16* Qb; bf16* Kb; bf16* Vb; bf16* Ub; float* QS; float* out;
    __device__ __forceinline__ void operator()(const f32x4 (&acc)[2][2][4][2], const pg8::Unit& u, int wr, int wc, int fr, int fq) const {
        const int pn = u.pn;
        const int rbase = u.pm * 256 + wr * 64 + fr;
        const int cl = wc * 32 + 8 * fq;
        if (pn < 6) {
            const int kind = pn >> 1, colh = (pn & 1) * 256;
#pragma unroll
            for (int ai = 0; ai < 2; ++ai)
#pragma unroll
                for (int m = 0; m < 4; ++m) {
                    const int row = rbase + ai * 128 + m * 16;
                    if (row < MR) {
#pragma unroll
                        for (int bj = 0; bj < 2; ++bj) {
                            const int col = colh + bj * 128 + cl;
                            f32x4 v0 = acc[ai][bj][m][0], v1 = acc[ai][bj][m][1];
                            if (kind == 0) {
                                v0 = v0 * C2; v1 = v1 * C2;
                                *(v4u*)(Qb + (size_t)row * DA + col) = pack8(v0, v1);
                                if (row >= MP) { float* q = QS + (size_t)(row - MP) * DA + col; *(f32x4*)q = v0; *(f32x4*)(q + 4) = v1; }
                            } else {
                                bf16* B = (kind == 1) ? Kb : Vb;
                                *(v4u*)(B + (size_t)row * DA + col) = pack8(v0, v1);
                                float* o = (row < MP) ? out + (kind == 1 ? O_KP : O_VP) + (size_t)row * DA + col
                                                      : out + (kind == 1 ? O_KS : O_VS) + (size_t)(row - MP) * DA + col;
                                *(f32x4*)o = v0; *(f32x4*)(o + 4) = v1;
                            }
                        }
                    }
                }
        } else {
            const int ch = (pn - 6) * 128 + cl;
#pragma unroll
            for (int ai = 0; ai < 2; ++ai)
#pragma unroll
                for (int m = 0; m < 4; ++m) {
                    const int row = rbase + ai * 128 + m * 16;
                    if (row < MR) {
                        f32x4 u0, u1;
#pragma unroll
                        for (int i = 0; i < 4; ++i) { u0[i] = acc[ai][0][m][0][i] * sigmoidf_fast(acc[ai][1][m][0][i]); u1[i] = acc[ai][0][m][1][i] * sigmoidf_fast(acc[ai][1][m][1][i]); }
                        *(v4u*)(Ub + (size_t)row * DC + ch) = pack8(u0, u1);
                        float* cs = nullptr;
                        if (row < MP) { const int t = row & (SEQ - 1); if (t >= SEQ - 30) cs = out + O_CP + ((size_t)(row >> 11) * 30 + (t - (SEQ - 30))) * DC + ch; }
                        else { const int r = row - MP; cs = out + O_CS + ((size_t)(r >> 2) * 30 + 26 + (r & 3)) * DC + ch; }
                        if (cs) { *(f32x4*)cs = u0; *(f32x4*)(cs + 4) = u1; }
                    }
                }
        }
    }
};
struct EpiF32 {
    static constexpr bool PERM = true, AFTER_DRAIN = false;
    float* O; int ldc;
    __device__ __forceinline__ void operator()(const f32x4 (&acc)[2][2][4][2], const pg8::Unit& u, int wr, int wc, int fr, int fq) const {
        const int rbase = u.pm * 256 + wr * 64 + fr, cb = u.pn * 256 + wc * 32 + 8 * fq;
#pragma unroll
        for (int ai = 0; ai < 2; ++ai)
#pragma unroll
            for (int m = 0; m < 4; ++m) { float* rp = O + (size_t)(rbase + ai * 128 + m * 16) * ldc + cb;
#pragma unroll
                for (int bj = 0; bj < 2; ++bj) { *(f32x4*)(rp + bj * 128) = acc[ai][bj][m][0]; *(f32x4*)(rp + bj * 128 + 4) = acc[ai][bj][m][1]; } }
    }
};
template <int ACT> struct EpiB16 {
    static constexpr bool PERM = true, AFTER_DRAIN = false;
    bf16* O; int ldc;
    __device__ __forceinline__ void operator()(const f32x4 (&acc)[2][2][4][2], const pg8::Unit& u, int wr, int wc, int fr, int fq) const {
        const int rbase = u.pm * 256 + wr * 64 + fr, cb = u.pn * 256 + wc * 32 + 8 * fq;
#pragma unroll
        for (int ai = 0; ai < 2; ++ai)
#pragma unroll
            for (int m = 0; m < 4; ++m) { bf16* rp = O + (size_t)(rbase + ai * 128 + m * 16) * ldc + cb;
#pragma unroll
                for (int bj = 0; bj < 2; ++bj) { f32x4 v0 = acc[ai][bj][m][0], v1 = acc[ai][bj][m][1];
                    if (ACT == 1) {
#pragma unroll
                        for (int i = 0; i < 4; ++i) { const float a = fmaxf(v0[i], 0.f), b = fmaxf(v1[i], 0.f); v0[i] = a * a; v1[i] = b * b; } }
                    *(v4u*)(rp + bj * 128) = pack8(v0, v1); } }
    }
};
struct EpiGate {
    static constexpr bool PERM = true, AFTER_DRAIN = false;
    const float* H2; const bf16* E; float* out;
    __device__ __forceinline__ void operator()(const f32x4 (&acc)[2][2][4][2], const pg8::Unit& u, int wr, int wc, int fr, int fq) const {
        const int rbase = u.pm * 256 + wr * 64 + fr, cb = u.pn * 256 + wc * 32 + 8 * fq;
#pragma unroll
        for (int ai = 0; ai < 2; ++ai)
#pragma unroll
            for (int m = 0; m < 4; ++m) {
                const int row = rbase + ai * 128 + m * 16;
                if (row < MR) {
                    float* op = (row < MP) ? out + O_YP + (size_t)row * DM + cb : out + O_YS + (size_t)(row - MP) * DM + cb;
#pragma unroll
                    for (int bj = 0; bj < 2; ++bj) {
                        const f32x4 h0 = *(const f32x4*)(H2 + (size_t)row * DM + cb + bj * 128), h1 = *(const f32x4*)(H2 + (size_t)row * DM + cb + bj * 128 + 4);
                        const v4u ev = *(const v4u*)(E + (size_t)row * DM + cb + bj * 128);
                        f32x4 e0, e1;
                        e0[0] = __uint_as_float(ev.x << 16); e0[1] = __uint_as_float(ev.x & 0xffff0000u); e0[2] = __uint_as_float(ev.y << 16); e0[3] = __uint_as_float(ev.y & 0xffff0000u);
                        e1[0] = __uint_as_float(ev.z << 16); e1[1] = __uint_as_float(ev.z & 0xffff0000u); e1[2] = __uint_as_float(ev.w << 16); e1[3] = __uint_as_float(ev.w & 0xffff0000u);
                        f32x4 y0, y1;
#pragma unroll
                        for (int i = 0; i < 4; ++i) { y0[i] = h0[i] + sigmoidf_fast(acc[ai][bj][m][0][i]) * e0[i]; y1[i] = h1[i] + sigmoidf_fast(acc[ai][bj][m][1][i]) * e1[i]; }
                        *(f32x4*)(op + bj * 128) = y0; *(f32x4*)(op + bj * 128 + 4) = y1;
                    }
                }
            }
    }
};


struct Frame {
    LAS unsigned char* lds;
    volatile LAS unsigned* MISC;
    gu32* ctl;
    int tid, lane, wave;
    int vcu, G;
};
__device__ __forceinline__ float wave_sum(float v) { return swap32_sum(swap16_sum(row16_sum(v))); }
__device__ __forceinline__ float bf_lo(unsigned w) { return __uint_as_float(w << 16); }
__device__ __forceinline__ float bf_hi(unsigned w) { return __uint_as_float(w & 0xffff0000u); }
__device__ __forceinline__ float alibi_slope2(int h) { return LOG2E * (h == 0 ? 0.25f : h == 1 ? 0.0625f : h == 2 ? 0.015625f : 0.00390625f); }
__device__ __forceinline__ float diff_lambda(const float* q1, const float* k1, const float* q2, const float* k2, int lane) {
    const float a = wave_sum(q1[lane] * k1[lane]), b = wave_sum(q2[lane] * k2[lane]);
    return __expf(a) - __expf(b) + LAM_INIT;
}

__device__ __forceinline__ void p0_transpose_item(const float* W, int K, int N, bf16* WT, int k0, int n0, int drow0, LAS float* scr, int lane) {
#pragma unroll 8
    for (int i = 0; i < 32; ++i) { const int kk = 2 * i + (lane >> 5); scr[kk * 33 + (lane & 31)] = W[(size_t)(k0 + kk) * N + n0 + (lane & 31)]; }
    LDS_WAIT(); asm volatile("" ::: "memory");
    const int c = lane & 7;
#pragma unroll
    for (int j = 0; j < 4; ++j) { const int n = (lane >> 3) + 8 * j; const LAS float* s = scr + (8 * c) * 33 + n;
        v4u o; o.x = pk2(s[0 * 33], s[1 * 33]); o.y = pk2(s[2 * 33], s[3 * 33]); o.z = pk2(s[4 * 33], s[5 * 33]); o.w = pk2(s[6 * 33], s[7 * 33]);
        *(GAS v4u*)(WT + (size_t)(drow0 + n) * K + k0 + 8 * c) = o; }
    LDS_WAIT(); asm volatile("" ::: "memory");
}
__device__ __forceinline__ int win_dest_row(int n0) {
    if (n0 < 3 * DA) return n0;
    if (n0 < 3 * DA + DC) { const int ch = n0 - 3 * DA; return 3 * DA + (ch >> 7) * 256 + (ch & 127); }
    const int ch = n0 - 3 * DA - DC; return 3 * DA + (ch >> 7) * 256 + 128 + (ch & 127);
}
__device__ __forceinline__ const float* x_row(const float* xp, const float* xs, int m) { return m < MP ? xp + (size_t)m * DM : xs + (size_t)(m - MP) * DM; }
__device__ __forceinline__ void rms_row_to_bf16(const float* xrow, const float* g, bf16* orow, int lane) {
    const GAS f32x4* xr = (const GAS f32x4*)xrow + lane; const GAS f32x4* gr = (const GAS f32x4*)g + lane;
    f32x4 v[4]; float s = 0.f;
#pragma unroll
    for (int j = 0; j < 4; ++j) { v[j] = xr[64 * j]; s += (v[j].x * v[j].x + v[j].y * v[j].y) + (v[j].z * v[j].z + v[j].w * v[j].w); }
    const float r = 1.f / sqrtf(wave_sum(s) * (1.f / DM) + EPS);
    GAS unsigned long long* o8 = (GAS unsigned long long*)orow + lane;
#pragma unroll
    for (int j = 0; j < 4; ++j) { const f32x4 gg = gr[64 * j]; o8[64 * j] = (unsigned long long)pk2(v[j].x * r * gg.x, v[j].y * r * gg.y) | ((unsigned long long)pk2(v[j].z * r * gg.z, v[j].w * r * gg.w) << 32); }
}
__device__ __forceinline__ void post_mix_row(const float* mmrow, const float* xrow, const float* g1, const float* g2, float* hrow, bf16* hnrow, int lane) {
    const GAS f32x4* mr = (const GAS f32x4*)mmrow + lane; const GAS f32x4* xr = (const GAS f32x4*)xrow + lane;
    const GAS f32x4* g1r = (const GAS f32x4*)g1 + lane; const GAS f32x4* g2r = (const GAS f32x4*)g2 + lane;
    f32x4 v[4]; float s = 0.f;
#pragma unroll
    for (int j = 0; j < 4; ++j) { v[j] = mr[64 * j]; s += (v[j].x * v[j].x + v[j].y * v[j].y) + (v[j].z * v[j].z + v[j].w * v[j].w); }
    const float r1 = 1.f / sqrtf(wave_sum(s) * (1.f / DM) + EPS);
    float s2 = 0.f;
#pragma unroll
    for (int j = 0; j < 4; ++j) { v[j] = xr[64 * j] + v[j] * r1 * g1r[64 * j]; s2 += (v[j].x * v[j].x + v[j].y * v[j].y) + (v[j].z * v[j].z + v[j].w * v[j].w); }
    const float r2 = 1.f / sqrtf(wave_sum(s2) * (1.f / DM) + EPS);
    GAS f32x4* ho = (GAS f32x4*)hrow + lane; GAS unsigned long long* o8 = (GAS unsigned long long*)hnrow + lane;
#pragma unroll
    for (int j = 0; j < 4; ++j) { ho[64 * j] = v[j]; const f32x4 gg = g2r[64 * j];
        o8[64 * j] = (unsigned long long)pk2(v[j].x * r2 * gg.x, v[j].y * r2 * gg.y) | ((unsigned long long)pk2(v[j].z * r2 * gg.z, v[j].w * r2 * gg.w) << 32); }
}
template <int NPART>
__device__ __forceinline__ void post_ffn_row(const float* ffrow, size_t pstride, const float* hrow, const float* g, float* h2row, bf16* h2brow, int lane) {
    const GAS f32x4* fr = (const GAS f32x4*)ffrow + lane; const GAS f32x4* hr = (const GAS f32x4*)hrow + lane; const GAS f32x4* gr = (const GAS f32x4*)g + lane;
    f32x4 v[4]; float s = 0.f;
#pragma unroll
    for (int j = 0; j < 4; ++j) { v[j] = fr[64 * j];
#pragma unroll
        for (int p = 1; p < NPART; ++p) v[j] = v[j] + *((const GAS f32x4*)(ffrow + (size_t)p * pstride) + lane + 64 * j);
        s += (v[j].x * v[j].x + v[j].y * v[j].y) + (v[j].z * v[j].z + v[j].w * v[j].w); }
    const float r1 = 1.f / sqrtf(wave_sum(s) * (1.f / DM) + EPS);
    GAS f32x4* ho = (GAS f32x4*)h2row + lane; GAS unsigned long long* o8 = (GAS unsigned long long*)h2brow + lane;
#pragma unroll
    for (int j = 0; j < 4; ++j) { const f32x4 y = hr[64 * j] + v[j] * r1 * gr[64 * j]; ho[64 * j] = y;
        o8[64 * j] = (unsigned long long)pk2(y.x, y.y) | ((unsigned long long)pk2(y.z, y.w) << 32); }
}
__device__ __forceinline__ void cvt_row256(const float* src, bf16* dst, int lane) {
    const f32x4 v = ((const GAS f32x4*)src)[lane];
    ((GAS unsigned long long*)dst)[lane] = (unsigned long long)pk2(v.x, v.y) | ((unsigned long long)pk2(v.z, v.w) << 32);
}

constexpr int CONV_WROWS = 37;
template <int KIND>
__device__ __forceinline__ void conv_group(const bf16* Ub, const float* state, float* cs_out, const LAS float* wl, const float* bdw, const float* lng, const float* lnb,
                                           bf16* Y2, int seq, int t0, int lane) {
    const int ch = 8 * lane;
    float acc[4][8];
    { const f32x4 b0 = *(const GAS f32x4*)(bdw + ch), b1 = *(const GAS f32x4*)(bdw + ch + 4);
#pragma unroll
      for (int o = 0; o < 4; ++o) { acc[o][0] = b0.x; acc[o][1] = b0.y; acc[o][2] = b0.z; acc[o][3] = b0.w; acc[o][4] = b1.x; acc[o][5] = b1.y; acc[o][6] = b1.z; acc[o][7] = b1.w; } }
    const size_t urow0 = (KIND == 0) ? (size_t)seq * SEQ : (size_t)MP + (size_t)seq * DS;
    const int i0 = (KIND == 0 && t0 < 30) ? 30 - t0 : 0;
#pragma unroll 2
    for (int i = i0; i < 34; ++i) {
        float u[8];
        if (KIND == 1 && i < 30) {
            const float* sp = state + ((size_t)seq * 30 + i) * DC + ch; const f32x4 a = *(const GAS f32x4*)sp, b = *(const GAS f32x4*)(sp + 4);
            u[0] = a.x; u[1] = a.y; u[2] = a.z; u[3] = a.w; u[4] = b.x; u[5] = b.y; u[6] = b.z; u[7] = b.w;
            if (i >= 4) { float* cp = cs_out + ((size_t)seq * 30 + (i - 4)) * DC + ch; *(GAS f32x4*)cp = a; *(GAS f32x4*)(cp + 4) = b; }
        } else {
            const size_t r = (KIND == 0) ? urow0 + (size_t)(t0 + i - 30) : urow0 + (size_t)(i - 30);
            const v4u w = *(const GAS v4u*)(Ub + r * DC + ch);
            u[0] = bf_lo(w.x); u[1] = bf_hi(w.x); u[2] = bf_lo(w.y); u[3] = bf_hi(w.y); u[4] = bf_lo(w.z); u[5] = bf_hi(w.z); u[6] = bf_lo(w.w); u[7] = bf_hi(w.w);
        }
        const LAS float* wr = wl + (i + 3) * DC + ch;
#pragma unroll
        for (int o = 0; o < 4; ++o) {
            const f32x4 w0 = *(const LAS f32x4*)(wr - o * DC), w1 = *(const LAS f32x4*)(wr - o * DC + 4);
            acc[o][0] = fmaf(w0.x, u[0], acc[o][0]); acc[o][1] = fmaf(w0.y, u[1], acc[o][1]); acc[o][2] = fmaf(w0.z, u[2], acc[o][2]); acc[o][3] = fmaf(w0.w, u[3], acc[o][3]);
            acc[o][4] = fmaf(w1.x, u[4], acc[o][4]); acc[o][5] = fmaf(w1.y, u[5], acc[o][5]); acc[o][6] = fmaf(w1.z, u[6], acc[o][6]); acc[o][7] = fmaf(w1.w, u[7], acc[o][7]);
        }
    }
    const f32x4 g0 = *(const GAS f32x4*)(lng + ch), g1 = *(const GAS f32x4*)(lng + ch + 4), c0 = *(const GAS f32x4*)(lnb + ch), c1 = *(const GAS f32x4*)(lnb + ch + 4);
    const float gg[8] = {g0.x, g0.y, g0.z, g0.w, g1.x, g1.y, g1.z, g1.w}, cc[8] = {c0.x, c0.y, c0.z, c0.w, c1.x, c1.y, c1.z, c1.w};
#pragma unroll
    for (int o = 0; o < 4; ++o) {
        float s = 0.f;
#pragma unroll
        for (int k = 0; k < 8; ++k) s += acc[o][k];
        const float mean = wave_sum(s) * (1.f / DC);
        float q = 0.f;
#pragma unroll
        for (int k = 0; k < 8; ++k) { const float d = acc[o][k] - mean; q = fmaf(d, d, q); }
        const float rstd = 1.f / sqrtf(wave_sum(q) * (1.f / DC) + EPS);
        float y[8];
#pragma unroll
        for (int k = 0; k < 8; ++k) { const float z = (acc[o][k] - mean) * rstd * gg[k] + cc[k]; y[k] = z * sigmoidf_fast(z); }
        v4u w; w.x = pk2(y[0], y[1]); w.y = pk2(y[2], y[3]); w.z = pk2(y[4], y[5]); w.w = pk2(y[6], y[7]);
        const size_t row = (KIND == 0) ? urow0 + t0 + o : urow0 + o;
        *(GAS v4u*)(Y2 + row * DM + DA + ch) = w;
    }
}

__device__ __forceinline__ f32x4 skinny_acc(f32x4 acc, const bf16* A, int lda, const bf16* Bt, int ldb, int n0, int k0, int kc, int wave, int lane) {
    const int r16 = lane & 15, kq = lane >> 4;
    const bf16* ap = A + (size_t)(16 * wave + r16) * lda + k0 + 8 * kq;
    const bf16* bp = Bt + (size_t)(n0 + r16) * ldb + k0 + 8 * kq;
    for (int k = 0; k < kc; k += 256) {
        bf16x8 a[8], b[8];
#pragma unroll
        for (int u = 0; u < 8; ++u) { a[u] = *(const GAS bf16x8*)(ap + k + 32 * u); b[u] = *(const GAS bf16x8*)(bp + k + 32 * u); }
#pragma unroll
        for (int u = 0; u < 8; ++u) acc = __builtin_amdgcn_mfma_f32_16x16x32_bf16(a[u], b[u], acc, 0, 0, 0);
    }
    return acc;
}


namespace att {
using bf16x8 = __attribute__((ext_vector_type(8))) short;
using s16x4  = __attribute__((ext_vector_type(4))) short;
using f32x16 = __attribute__((ext_vector_type(16))) float;
using u32x4  = __attribute__((ext_vector_type(4))) unsigned;
constexpr int KVBLK = 64, LD = 512;
constexpr int SHM_V = 64 * 128 * 2, SHM_K = 64 * 128 * 2;
constexpr int LDS_V = 0, LDS_K = 2 * SHM_V, LDS_WS = 2 * SHM_V + 2 * SHM_K, LDS_END = LDS_WS + 8 * 64 * 4;
constexpr float THR2 = 8.0f;
#define ASBAR() __builtin_amdgcn_sched_barrier(0)
__device__ __forceinline__ int crow(int r, int hi) { return (r & 3) + 8 * (r >> 2) + 4 * hi; }
__device__ __forceinline__ unsigned cvtpk(float lo, float hi) { unsigned r; asm volatile("v_cvt_pk_bf16_f32 %0, %1, %2" : "=v"(r) : "v"(lo), "v"(hi)); return r; }
__device__ __forceinline__ int k_st(int key, int ch16) { return ch16 * 1024 + ((key ^ (ch16 & 7)) << 4); }
__device__ __forceinline__ int v_st(int k, int c) { const int kk = (k & ~0xC) | ((k & 4) << 1) | ((k & 8) >> 1); return ((kk >> 3) * 4 + (c >> 5)) * 512 + ((kk & 7) * 32 + (c & 31)) * 2; }
__device__ __forceinline__ int v_rd_base(int lane) { return ((lane & 3) << 3) | (((lane >> 2) & 3) << 6) | (((lane >> 4) & 1) << 5) | (((lane >> 5) & 1) << 8); }
constexpr int v_rd_off(int d0, int ks, int half) { return d0 * 512 + ks * 4096 + half * 2048; }
template <int OFF> __device__ __forceinline__ s16x4 tr_read(int vb) { s16x4 r; asm volatile("ds_read_b64_tr_b16 %0, %1 offset:%2" : "=&v"(r) : "v"(vb), "i"(OFF) : "memory"); return r; }

__device__ __forceinline__ void partialSM(f32x16& p0, f32x16& p1, float& m_reg, float& alpha) {
  float pmax = p0[0];
#pragma unroll
  for (int r = 1; r < 16; ++r) pmax = fmaxf(pmax, p0[r]);
#pragma unroll
  for (int r = 0; r < 16; ++r) pmax = fmaxf(pmax, p1[r]);
  { auto rr = __builtin_amdgcn_permlane32_swap(__float_as_uint(pmax), __float_as_uint(pmax), false, false); pmax = fmaxf(__uint_as_float(rr[0]), __uint_as_float(rr[1])); }
  float mn;
  if (__builtin_expect(__all(pmax - m_reg <= THR2), 1)) { mn = m_reg; alpha = 1.f; }
  else { mn = fmaxf(m_reg, pmax); alpha = __builtin_amdgcn_exp2f(m_reg - mn); m_reg = mn; }
#pragma unroll
  for (int r = 0; r < 16; ++r) p0[r] = p0[r] - mn;
#pragma unroll
  for (int r = 0; r < 16; ++r) p1[r] = p1[r] - mn;
#pragma unroll
  for (int r = 0; r < 16; ++r) p0[r] = __builtin_amdgcn_exp2f(p0[r]);
}
__device__ __forceinline__ void finishSM(f32x16& p0, f32x16& p1, float alpha, float& l_reg, bf16x8& pa0, bf16x8& pa1, bf16x8& pa2, bf16x8& pa3) {
#pragma unroll
  for (int r = 0; r < 16; ++r) p1[r] = __builtin_amdgcn_exp2f(p1[r]);
  float ps = 0;
#pragma unroll
  for (int r = 0; r < 16; ++r) ps += p0[r];
#pragma unroll
  for (int r = 0; r < 16; ++r) ps += p1[r];
  { auto rr = __builtin_amdgcn_permlane32_swap(__float_as_uint(ps), __float_as_uint(ps), false, false); ps = __uint_as_float(rr[0]) + __uint_as_float(rr[1]); }
  l_reg = l_reg * alpha + ps;
#define PK4(P, BASE, OUT) do { unsigned a0 = cvtpk(P[BASE + 0], P[BASE + 1]), a1 = cvtpk(P[BASE + 2], P[BASE + 3]);   \
    unsigned b0 = cvtpk(P[BASE + 4], P[BASE + 5]), b1 = cvtpk(P[BASE + 6], P[BASE + 7]);                              \
    auto r0 = __builtin_amdgcn_permlane32_swap(a0, b0, false, false); auto r1 = __builtin_amdgcn_permlane32_swap(a1, b1, false, false); \
    u32x4 w = {r0[0], r1[0], r0[1], r1[1]}; OUT = *reinterpret_cast<bf16x8*>(&w); } while (0)
  PK4(p0, 0, pa0); PK4(p0, 8, pa1); PK4(p1, 0, pa2); PK4(p1, 8, pa3);
#undef PK4
}
__device__ __forceinline__ void qkt(f32x16& p0, f32x16& p1, const char* Ks, const bf16x8* qr, int r32, int hi, int comp, float slope2, float sb) {
#pragma unroll
  for (int r = 0; r < 16; ++r) { const float cr = (float)((r & 3) + 8 * (r >> 2)); p0[r] = fmaf(slope2, cr, sb); p1[r] = fmaf(slope2, cr + 32.f, sb); }
#pragma unroll
  for (int d0 = 0; d0 < 4; ++d0) { const int ch = comp * 8 + 2 * d0 + hi;
    const bf16x8 b0 = *reinterpret_cast<const bf16x8*>(Ks + k_st(r32, ch));
    const bf16x8 b1 = *reinterpret_cast<const bf16x8*>(Ks + k_st(32 + r32, ch));
    p0 = __builtin_amdgcn_mfma_f32_32x32x16_bf16(b0, qr[d0], p0, 0, 0, 0);
    p1 = __builtin_amdgcn_mfma_f32_32x32x16_bf16(b1, qr[d0], p1, 0, 0, 0); }
}
__device__ __forceinline__ void cmask(f32x16& p0, f32x16& p1, int krel, int qrel, int hi) {
  const int kb = krel + 4 * hi;
#pragma unroll
  for (int r = 0; r < 16; ++r) { const int kv = kb + (r & 3) + 8 * (r >> 2); if (kv > qrel) p0[r] = -INFINITY; if (kv + 32 > qrel) p1[r] = -INFINITY; }
}
template <int D0> __device__ __forceinline__ void pv_one(f32x16& od, int vb, bf16x8 pa0, bf16x8 pa1, bf16x8 pa2, bf16x8 pa3) {
  const s16x4 l0 = tr_read<v_rd_off(D0, 0, 0)>(vb), h0 = tr_read<v_rd_off(D0, 0, 1)>(vb), l1 = tr_read<v_rd_off(D0, 1, 0)>(vb), h1 = tr_read<v_rd_off(D0, 1, 1)>(vb);
  const s16x4 l2 = tr_read<v_rd_off(D0, 2, 0)>(vb), h2 = tr_read<v_rd_off(D0, 2, 1)>(vb), l3 = tr_read<v_rd_off(D0, 3, 0)>(vb), h3 = tr_read<v_rd_off(D0, 3, 1)>(vb);
  asm volatile("s_waitcnt lgkmcnt(0)" ::: "memory"); ASBAR();
#define PK(L, H) (bf16x8){L[0], L[1], L[2], L[3], H[0], H[1], H[2], H[3]}
  od = __builtin_amdgcn_mfma_f32_32x32x16_bf16(pa0, PK(l0, h0), od, 0, 0, 0);
  od = __builtin_amdgcn_mfma_f32_32x32x16_bf16(pa1, PK(l1, h1), od, 0, 0, 0);
  od = __builtin_amdgcn_mfma_f32_32x32x16_bf16(pa2, PK(l2, h2), od, 0, 0, 0);
  od = __builtin_amdgcn_mfma_f32_32x32x16_bf16(pa3, PK(l3, h3), od, 0, 0, 0);
#undef PK
}
__device__ __forceinline__ void pv_d0(f32x16* o, int vb, bf16x8 pa0, bf16x8 pa1, bf16x8 pa2, bf16x8 pa3) {
  pv_one<0>(o[0], vb, pa0, pa1, pa2, pa3); pv_one<1>(o[1], vb, pa0, pa1, pa2, pa3); pv_one<2>(o[2], vb, pa0, pa1, pa2, pa3); pv_one<3>(o[3], vb, pa0, pa1, pa2, pa3);
}

__device__ __forceinline__ void attn_unit(const unsigned short* __restrict__ Qb, const unsigned short* __restrict__ Kh, const unsigned short* __restrict__ Vh, unsigned short* __restrict__ Yb,
                                          int q0, float slope2, float lam, const float* __restrict__ gsub, char* lds, int tid_in) {
  int tid_ = tid_in; asm volatile("" : "+v"(tid_));
  const int tid = tid_, wid = tid >> 6, lane = tid & 63, r32 = lane & 31, hi = lane >> 5, comp = wid >> 2, w4 = wid & 3;
  char* V_lds = lds + LDS_V; char* K_lds = lds + LDS_K;
  float* wsf = (float*)(lds + LDS_WS) + wid * 64; float* li_l = wsf; float* al_l = wsf + 32;
  float m_reg = -1e30f, l_reg = 0.f; f32x16 o[4] = {}; bf16x8 qr[4];
  const unsigned short* Qw = Qb + (size_t)(w4 * 32 + r32) * LD + comp * 64 + hi * 8;
#pragma unroll
  for (int d0 = 0; d0 < 4; ++d0) qr[d0] = *reinterpret_cast<const bf16x8*>(Qw + d0 * 16);
  const int sr = tid >> 4, sc = (tid & 15) * 8;
  const int vst0 = v_st(sr, sc), vst1 = v_st(32 + sr, sc), kst0 = k_st(sr, tid & 15), kst1 = k_st(32 + sr, tid & 15);
  const int vb0 = (int)(uintptr_t)V_lds + v_rd_base(lane);
  struct { bf16x8 vs0, vs1, ks0, ks1; } sr_[1];
#define SLOAD(i, k0) do { sr_[i].vs0 = *reinterpret_cast<const bf16x8*>(&Vh[(size_t)((k0) + sr) * LD + sc]); sr_[i].vs1 = *reinterpret_cast<const bf16x8*>(&Vh[(size_t)((k0) + 32 + sr) * LD + sc]); \
    sr_[i].ks0 = *reinterpret_cast<const bf16x8*>(&Kh[(size_t)((k0) + sr) * LD + sc]); sr_[i].ks1 = *reinterpret_cast<const bf16x8*>(&Kh[(size_t)((k0) + 32 + sr) * LD + sc]); } while (0)
#define SWRITE(b, i) do { *(bf16x8*)(V_lds + (b) * SHM_V + vst0) = sr_[i].vs0; *(bf16x8*)(V_lds + (b) * SHM_V + vst1) = sr_[i].vs1; \
    *(bf16x8*)(K_lds + (b) * SHM_K + kst0) = sr_[i].ks0; *(bf16x8*)(K_lds + (b) * SHM_K + kst1) = sr_[i].ks1; } while (0)
#define SWAIT() asm volatile("s_waitcnt vmcnt(0)" ::: "memory")
#define RESC(a) do { if (__any((a) < 1.f)) { if (hi == 0) al_l[r32] = (a); asm volatile("s_waitcnt lgkmcnt(0)" ::: "memory"); \
    _Pragma("unroll") for (int d = 0; d < 4; ++d) _Pragma("unroll") for (int r = 0; r < 16; ++r) o[d][r] *= al_l[crow(r, hi)]; } } while (0)
  const int NT = (q0 + 128) / KVBLK;
  const int qrel = w4 * 32 + r32, qpos = q0 + qrel;
#define SB(t) (slope2 * (float)(64 * (t) + 4 * hi - qpos))
#define MASK(P0, P1, t) do { if ((t) >= NT - 2) cmask(P0, P1, 64 * (t) - q0, qrel, hi); } while (0)
  f32x16 pA0, pA1, pB0, pB1; float alA, alB; bf16x8 pa0, pa1, pa2, pa3;
  SLOAD(0, 0); asm volatile("s_waitcnt vmcnt(0)" ::: "memory"); SWRITE(0, 0); __syncthreads();
  qkt(pA0, pA1, K_lds, qr, r32, hi, comp, slope2, SB(0)); MASK(pA0, pA1, 0); partialSM(pA0, pA1, m_reg, alA);
  SLOAD(0, KVBLK);
  SWAIT(); SWRITE(1, 0); __syncthreads();
  for (int j = 1; j + 1 < NT; j += 2) {
    ASBAR(); qkt(pB0, pB1, K_lds + SHM_K, qr, r32, hi, comp, slope2, SB(j)); MASK(pB0, pB1, j);
    finishSM(pA0, pA1, alA, l_reg, pa0, pa1, pa2, pa3); ASBAR();
    SLOAD(0, (j + 1) * KVBLK); ASBAR();
    pv_d0(o, vb0, pa0, pa1, pa2, pa3); partialSM(pB0, pB1, m_reg, alB);
    __syncthreads(); SWAIT(); SWRITE(0, 0);
    RESC(alB); __syncthreads();
    ASBAR(); qkt(pA0, pA1, K_lds, qr, r32, hi, comp, slope2, SB(j + 1)); MASK(pA0, pA1, j + 1);
    finishSM(pB0, pB1, alB, l_reg, pa0, pa1, pa2, pa3); ASBAR();
    SLOAD(0, (j + 2) * KVBLK); ASBAR();
    pv_d0(o, vb0 + SHM_V, pa0, pa1, pa2, pa3); partialSM(pA0, pA1, m_reg, alA);
    __syncthreads(); SWAIT(); SWRITE(1, 0);
    RESC(alA); __syncthreads();
  }
  ASBAR(); qkt(pB0, pB1, K_lds + SHM_K, qr, r32, hi, comp, slope2, SB(NT - 1)); MASK(pB0, pB1, NT - 1);
  finishSM(pA0, pA1, alA, l_reg, pa0, pa1, pa2, pa3); ASBAR();
  pv_d0(o, vb0, pa0, pa1, pa2, pa3); partialSM(pB0, pB1, m_reg, alB);
  __syncthreads(); RESC(alB);
  finishSM(pB0, pB1, alB, l_reg, pa0, pa1, pa2, pa3); ASBAR();
  pv_d0(o, vb0 + SHM_V, pa0, pa1, pa2, pa3);
  int lane_e = lane_id_v();
  { const int r32 = lane_e & 31, hi = lane_e >> 5, lane = lane_e;
  if (hi == 0) li_l[r32] = l_reg; asm volatile("s_waitcnt lgkmcnt(0)" ::: "memory");
#pragma unroll
  for (int r = 0; r < 16; ++r) { const float rl = __builtin_amdgcn_rcpf(li_l[crow(r, hi)]);
#pragma unroll
    for (int d0 = 0; d0 < 4; ++d0) o[d0][r] *= rl; }
  __syncthreads();
  float* xch = (float*)lds + (size_t)w4 * 4096 + lane;
  if (comp == 1) {
#pragma unroll
    for (int d0 = 0; d0 < 4; ++d0)
#pragma unroll
      for (int r = 0; r < 16; ++r) xch[(d0 * 16 + r) * 64] = o[d0][r];
  }
  __syncthreads();
  if (comp == 0) {
    float ss[16];
#pragma unroll
    for (int r = 0; r < 16; ++r) ss[r] = 0.f;
#pragma unroll
    for (int d0 = 0; d0 < 4; ++d0)
#pragma unroll
      for (int r = 0; r < 16; ++r) { const float v = o[d0][r] - lam * xch[(d0 * 16 + r) * 64]; o[d0][r] = v; ss[r] = fmaf(v, v, ss[r]); }
#pragma unroll
    for (int r = 0; r < 16; ++r) {
      float s = ss[r];
      s = swap16_sum(row16_sum(s));
      ss[r] = (1.0f - LAM_INIT) / sqrtf(s * (1.0f / 128.0f) + EPS);
    }
    float g[4];
#pragma unroll
    for (int d0 = 0; d0 < 4; ++d0) g[d0] = gsub[d0 * 32 + r32];
    unsigned short* Yw = Yb + (size_t)(w4 * 32) * DM;
#pragma unroll
    for (int r = 0; r < 16; ++r) { const int orow = crow(r, hi);
#pragma unroll
      for (int d0 = 0; d0 < 4; ++d0) Yw[(size_t)orow * DM + d0 * 32 + r32] = (unsigned short)f2bf(o[d0][r] * ss[r] * g[d0]); }
  }
  }
  __syncthreads();
#undef SLOAD
#undef SWRITE
#undef SWAIT
#undef RESC
#undef SB
#undef MASK
}
#undef ASBAR
}


namespace dec {
constexpr int PPW = 4, CPP = PAGE / 16, NCH = PPW * CPP;
constexpr int MREC = 136;

__device__ __forceinline__ void decode_unit(const float* __restrict__ QS, const float* __restrict__ ck, const float* __restrict__ cv, const int* __restrict__ pt,
                                            float* __restrict__ part, int s, int h, int split, LAS float* mrg, int tid_in) {
    int tid_ = tid_in; asm volatile("" : "+v"(tid_));
    const int tid = tid_, lane = tid & 63, wave = __builtin_amdgcn_readfirstlane(tid >> 6), kk = lane >> 5, dl = lane & 31, comp = dl >> 4;
    const float slope2 = alibi_slope2(h);
    f32x4 Qr[DS];
#pragma unroll
    for (int q = 0; q < DS; ++q) Qr[q] = *(const GAS f32x4*)(QS + (size_t)(s * DS + q) * DA + h * 128 + dl * 4);
    float m[DS], l[DS]; f32x4 aown[DS], aoth[DS];
#pragma unroll
    for (int q = 0; q < DS; ++q) { m[q] = -1e30f; l[q] = 0.f; aown[q] = (f32x4){0.f, 0.f, 0.f, 0.f}; aoth[q] = (f32x4){0.f, 0.f, 0.f, 0.f}; }
    const int page0 = split * (NPAGES / DSPLIT) + wave * PPW;
    const size_t loff = (size_t)kk * DA + h * 128 + dl * 4;
    f32x4 Kn[8], Vn[8];
#define DISSUE(ci_) do { const int pg_ = page0 + ((ci_) >> 3); const int phys_ = __builtin_amdgcn_readfirstlane(pt[s * NPAGES + pg_]); \
        const size_t base_ = ((size_t)phys_ * PAGE + (size_t)((ci_) & 7) * 16) * DA + loff; \
        _Pragma("unroll") for (int i_ = 0; i_ < 8; ++i_) { Kn[i_] = __builtin_nontemporal_load((const GAS f32x4*)(ck + base_ + (size_t)i_ * 2 * DA)); \
                                                          Vn[i_] = __builtin_nontemporal_load((const GAS f32x4*)(cv + base_ + (size_t)i_ * 2 * DA)); } } while (0)
    DISSUE(0);
    for (int ci = 0; ci < NCH; ++ci) {
        f32x4 Kc[8], Vc[8];
#pragma unroll
        for (int i = 0; i < 8; ++i) { Kc[i] = Kn[i]; Vc[i] = Vn[i]; }
        if (ci + 1 < NCH) DISSUE(ci + 1);
        const int kpos0 = (page0 + (ci >> 3)) * PAGE + (ci & 7) * 16 + kk;
        float sc[8][DS];
#pragma unroll
        for (int i = 0; i < 8; ++i)
#pragma unroll
            for (int q = 0; q < DS; ++q) {
                float d = Kc[i].x * Qr[q].x; d = fmaf(Kc[i].y, Qr[q].y, d); d = fmaf(Kc[i].z, Qr[q].z, d); d = fmaf(Kc[i].w, Qr[q].w, d);
                d = row16_sum(d);
                sc[i][q] = fmaf(slope2, (float)(kpos0 + 2 * i - (PAST + q)), d);
            }
        float al[DS];
#pragma unroll
        for (int q = 0; q < DS; ++q) {
            float cm = sc[0][q];
#pragma unroll
            for (int i = 1; i < 8; ++i) cm = fmaxf(cm, sc[i][q]);
            cm = swap32_max(cm);
            const float mn = fmaxf(m[q], cm);
            al[q] = __builtin_amdgcn_exp2f(m[q] - mn); m[q] = mn;
            float ls = 0.f;
#pragma unroll
            for (int i = 0; i < 8; ++i) { sc[i][q] = __builtin_amdgcn_exp2f(sc[i][q] - mn); ls += sc[i][q]; }
            l[q] = fmaf(l[q], al[q], ls);
        }
#pragma unroll
        for (int q = 0; q < DS; ++q) { const float ao = other16(al[q], comp != 0); aown[q] = aown[q] * al[q]; aoth[q] = aoth[q] * ao; }
#pragma unroll
        for (int i = 0; i < 8; ++i)
#pragma unroll
            for (int q = 0; q < DS; ++q) { const float p = sc[i][q], po = other16(p, comp != 0);
                aown[q].x = fmaf(p, Vc[i].x, aown[q].x); aown[q].y = fmaf(p, Vc[i].y, aown[q].y); aown[q].z = fmaf(p, Vc[i].z, aown[q].z); aown[q].w = fmaf(p, Vc[i].w, aown[q].w);
                aoth[q].x = fmaf(po, Vc[i].x, aoth[q].x); aoth[q].y = fmaf(po, Vc[i].y, aoth[q].y); aoth[q].z = fmaf(po, Vc[i].z, aoth[q].z); aoth[q].w = fmaf(po, Vc[i].w, aoth[q].w); }
    }
#undef DISSUE
#pragma unroll
    for (int q = 0; q < DS; ++q) {
        l[q] = swap32_sum(l[q]);
        aown[q].x = swap32_sum(aown[q].x); aown[q].y = swap32_sum(aown[q].y); aown[q].z = swap32_sum(aown[q].z); aown[q].w = swap32_sum(aown[q].w);
        aoth[q].x = swap32_sum(aoth[q].x); aoth[q].y = swap32_sum(aoth[q].y); aoth[q].z = swap32_sum(aoth[q].z); aoth[q].w = swap32_sum(aoth[q].w);
    }
    if (kk == 0) {
#pragma unroll
        for (int q = 0; q < DS; ++q) {
            LAS float* ro = mrg + (size_t)((wave * 2 + comp) * DS + q) * MREC; LAS float* rx = mrg + (size_t)((wave * 2 + (comp ^ 1)) * DS + q) * MREC;
            *(LAS f32x4*)(ro + 8 + dl * 4) = aown[q]; *(LAS f32x4*)(rx + 8 + dl * 4) = aoth[q];
            if ((dl & 15) == 0) { ro[0] = m[q]; ro[1] = l[q]; }
        }
    }
    __syncthreads();
    {
        const int e = tid & 127;
#pragma unroll
        for (int t = 0; t < 2; ++t) {
            const int cq = (tid >> 7) + 4 * t;
            float M = -1e30f;
#pragma unroll
            for (int w = 0; w < NWAVES; ++w) M = fmaxf(M, mrg[(size_t)(w * 8 + cq) * MREC]);
            float L = 0.f, O = 0.f;
#pragma unroll
            for (int w = 0; w < NWAVES; ++w) { const LAS float* r = mrg + (size_t)(w * 8 + cq) * MREC; const float wt = __builtin_amdgcn_exp2f(r[0] - M); L = fmaf(wt, r[1], L); O = fmaf(wt, r[8 + e], O); }
            float* pr = part + ((size_t)((s * NH + h) * DSPLIT + split) * 8 + cq) * PREC;
            pr[4 + e] = O; if (e == 0) { pr[0] = M; pr[1] = L; }
        }
    }
    __syncthreads();
}

__device__ __forceinline__ void decode_finish(const float* __restrict__ QS, const float* __restrict__ KS, const float* __restrict__ VS, const float* __restrict__ part,
                                              const float* __restrict__ gsub, float lam, bf16* __restrict__ Y2, int s, int h, int q, int lane) {
    const float slope2 = alibi_slope2(h);
    float oc[2][2];
#pragma unroll
    for (int c = 0; c < 2; ++c) {
        float sn[DS];
        const float qv = QS[(size_t)(s * DS + q) * DA + h * 128 + c * 64 + lane];
#pragma unroll
        for (int j = 0; j < DS; ++j) { const float d = wave_sum(qv * KS[(size_t)(s * DS + j) * DA + h * 128 + c * 64 + lane]); sn[j] = (j <= q) ? fmaf(slope2, (float)(j - q), d) : -INFINITY; }
        float M = sn[0];
#pragma unroll
        for (int j = 1; j < DS; ++j) M = fmaxf(M, sn[j]);
        const float* pr[DSPLIT];
#pragma unroll
        for (int sp = 0; sp < DSPLIT; ++sp) { pr[sp] = part + ((size_t)((s * NH + h) * DSPLIT + sp) * 8 + c * DS + q) * PREC; M = fmaxf(M, pr[sp][0]); }
        float L = 0.f, o0 = 0.f, o1 = 0.f;
#pragma unroll
        for (int sp = 0; sp < DSPLIT; ++sp) { const float wt = __builtin_amdgcn_exp2f(pr[sp][0] - M); L = fmaf(wt, pr[sp][1], L); o0 = fmaf(wt, pr[sp][4 + 2 * lane], o0); o1 = fmaf(wt, pr[sp][4 + 2 * lane + 1], o1); }
#pragma unroll
        for (int j = 0; j < DS; ++j) { const float p = __builtin_amdgcn_exp2f(sn[j] - M); const float* vr = VS + (size_t)(s * DS + j) * DA + h * 128 + 2 * lane;
            L += p; o0 = fmaf(p, vr[0], o0); o1 = fmaf(p, vr[1], o1); }
        const float inv = 1.f / L;
        oc[c][0] = o0 * inv; oc[c][1] = o1 * inv;
    }
    const float a0 = oc[0][0] - lam * oc[1][0], a1 = oc[0][1] - lam * oc[1][1];
    const float r = (1.0f - LAM_INIT) / sqrtf(wave_sum(a0 * a0 + a1 * a1) * (1.f / 128.f) + EPS);
    *(GAS unsigned*)(Y2 + (size_t)(MP + s * DS + q) * DM + h * 128 + 2 * lane) = pk2(a0 * r * gsub[2 * lane], a1 * r * gsub[2 * lane + 1]);
}
}


struct Args { const float* in[27]; float* out; unsigned char* ws; int k_dm, k_ff, k_ple, pad; };
template <int LO, int HI>
__global__ void __launch_bounds__(NWAVES * 64, 2) mk_fwd(Args args) {
    extern __shared__ __attribute__((aligned(16))) unsigned char lds[];
    Frame F;
    F.lds = (LAS unsigned char*)lds;
    F.MISC = (volatile LAS unsigned*)(F.lds + MISC_OFF);
    F.tid = threadIdx.x; F.lane = F.tid & 63; F.wave = __builtin_amdgcn_readfirstlane(F.tid >> 6);
    F.G = gridDim.x; { const int bx = blockIdx.x; F.vcu = (F.G % 8 == 0) ? (bx % 8) * (F.G / 8) + bx / 8 : bx; }
    F.ctl = (gu32*)(args.ws + WS_CTL);

#define IN(k) (LO <= (k) && (k) < HI)
#define MYTID() (F.wave * 64 + lane_id_v())
#define KARGS() const __attribute__((address_space(4))) Args* ap = (const __attribute__((address_space(4))) Args*)__builtin_amdgcn_kernarg_segment_ptr(); asm volatile("" : "+s"(ap)); \
    unsigned char* const ws = ap->ws; float* const out = ap->out; (void)ws; (void)out
#define WSP(T, off) ((T*)(ws + (off)))
#define PHASE_LANE() int tl_ = MYTID(); asm volatile("" : "+v"(tl_)); const int ptid = tl_, plane = tl_ & 63; (void)ptid; (void)plane
#define SEAM(k) do { if constexpr (IN(k) && IN((k) + 1)) xcd_barrier(bar); } while (0)
    for (int u = F.tid; u < (LDS_BYTES - LDSCTL_OFF) / 4; u += NWAVES * 64) ((LAS unsigned*)(F.lds + LDSCTL_OFF))[u] = 0u;
    __syncthreads();
    XcdBarrier bar; bar.bar = (unsigned*)(F.ctl + CW_BAR); bar.x = 0; bar.st = nullptr; bar.wv = (unsigned)F.wave;
    if constexpr (HI - LO > 1) bar = xcd_barrier_post((unsigned*)(F.ctl + CW_BAR), F.MISC + 8, (unsigned)F.wave);
    const int gw = F.vcu * NWAVES + F.wave, NGW = F.G * NWAVES;

    if constexpr (IN(0)) {
        PHASE_LANE(); KARGS();
        const float* x_p = ap->in[0]; const float* x_s = ap->in[1]; const float* p_p = ap->in[6]; const float* p_s = ap->in[7]; const float* g_pre_mix = ap->in[19];
        bf16* XN = WSP(bf16, WS_XN); bf16* PEb = WSP(bf16, WS_PE);
        LAS float* scr = (LAS float*)(F.lds + RING_OFF + F.wave * 16384);
        constexpr int I_IN = (DM / 64) * (NIN / 32), I_OUT = (DM / 64) * (DM / 32), I_F1 = (DM / 64) * (DFF / 32), I_F2 = (DFF / 64) * (DM / 32), I_G = I_OUT, I_P = (DPLE / 64) * (DM / 32);
        constexpr int NITEMS = I_IN + I_OUT + I_F1 + I_F2 + I_G + I_P;
        for (int it = gw; it < NITEMS; it += NGW) {
            int r = it;
            if (r < I_IN) { const int nblk = NIN / 32, kb = r / nblk, nb = r % nblk; p0_transpose_item(ap->in[8], DM, NIN, WSP(bf16, WS_WIN), 64 * kb, 32 * nb, win_dest_row(32 * nb), scr, plane); continue; } r -= I_IN;
            if (r < I_OUT) { const int nblk = DM / 32, kb = r / nblk, nb = r % nblk; p0_transpose_item(ap->in[9], DM, DM, WSP(bf16, WS_WOUT), 64 * kb, 32 * nb, 32 * nb, scr, plane); continue; } r -= I_OUT;
            if (r < I_F1) { const int nblk = DFF / 32, kb = r / nblk, nb = r % nblk; p0_transpose_item(ap->in[23], DM, DFF, WSP(bf16, WS_WFF1), 64 * kb, 32 * nb, 32 * nb, scr, plane); continue; } r -= I_F1;
            if (r < I_F2) { const int nblk = DM / 32, kb = r / nblk, nb = r % nblk; p0_transpose_item(ap->in[24], DFF, DM, WSP(bf16, WS_WFF2), 64 * kb, 32 * nb, 32 * nb, scr, plane); continue; } r -= I_F2;
            if (r < I_G) { const int nblk = DM / 32, kb = r / nblk, nb = r % nblk; p0_transpose_item(ap->in[26], DM, DM, WSP(bf16, WS_WGATE), 64 * kb, 32 * nb, 32 * nb, scr, plane); continue; } r -= I_G;
            { const int nblk = DM / 32, kb = r / nblk, nb = r % nblk; p0_transpose_item(ap->in[25], DPLE, DM, WSP(bf16, WS_WPLE), 64 * kb, 32 * nb, 32 * nb, scr, plane); }
        }
        for (int m = gw; m < MR; m += NGW) {
            rms_row_to_bf16(x_row(x_p, x_s, m), g_pre_mix, XN + (size_t)m * DM, plane);
            cvt_row256(m < MP ? p_p + (size_t)m * DPLE : p_s + (size_t)(m - MP) * DPLE, PEb + (size_t)m * DPLE, plane);
        }
        for (int m = MR + gw; m < MT; m += NGW) {
            ((GAS unsigned long long*)(XN + (size_t)m * DM))[plane] = 0ull; ((GAS unsigned long long*)(XN + (size_t)m * DM))[64 + plane] = 0ull;
            ((GAS unsigned long long*)(XN + (size_t)m * DM))[128 + plane] = 0ull; ((GAS unsigned long long*)(XN + (size_t)m * DM))[192 + plane] = 0ull;
            ((GAS unsigned long long*)(PEb + (size_t)m * DPLE))[plane] = 0ull;
        }
    }
    SEAM(0);

    if constexpr (IN(1)) {
        KARGS();
        {
            pg8::Gemm g{WSP(bf16, WS_XN), WSP(bf16, WS_WIN), MT, NIN, ap->k_dm}; pg8::StaticOrder S; S.init(MT, NIN, F.G, (int)blockIdx.x);
            EpiIn E{WSP(bf16, WS_Q), WSP(bf16, WS_K), WSP(bf16, WS_V), WSP(bf16, WS_U), WSP(float, WS_QS), out};
            pg8::gemm_phase<EpiIn, pg8::StaticOrder, true, true>(F.lds + RING_OFF, g, S, E, MYTID());
        }
        {
            pg8::Gemm g{WSP(bf16, WS_PE), WSP(bf16, WS_WPLE), MP, DM, ap->k_ple}; pg8::StaticOrder S; S.init(MP, DM, F.G, (int)blockIdx.x);
            EpiB16<0> E{WSP(bf16, WS_E), DM};
            pg8::gemm_phase<EpiB16<0>, pg8::StaticOrder, true, true>(F.lds + RING_OFF, g, S, E, MYTID());
        }
    }
    SEAM(1);

    const bool DEC_FIRST = ((blockIdx.x >> 3) & 1) != 0;
    if constexpr (IN(4)) { if (DEC_FIRST) {
        KARGS();
        const float* cache_k = ap->in[2]; const float* cache_v = ap->in[3]; const int* page_table = (const int*)ap->in[5]; float* QS = WSP(float, WS_QS); float* DP = WSP(float, WS_DP);
        for (int du = F.vcu; du < DB * NH * DSPLIT; du += F.G) {
            const int s = du >> 3, h = (du >> 1) & 3, sp = du & 1;
            dec::decode_unit(QS, cache_k, cache_v, page_table, DP, s, h, sp, (LAS float*)(F.lds + RING_OFF), MYTID());
        }
    } }
    if constexpr (IN(2)) {
        PHASE_LANE(); KARGS();
        const float* lq1 = ap->in[10]; const float* lk1 = ap->in[11]; const float* lq2 = ap->in[12]; const float* lk2 = ap->in[13]; const float* g_subln = ap->in[14];
        bf16* Qb = WSP(bf16, WS_Q); bf16* Kb = WSP(bf16, WS_K); bf16* Vb = WSP(bf16, WS_V); bf16* Y2 = WSP(bf16, WS_Y2);
        const float lam = __builtin_bit_cast(float, __builtin_amdgcn_readfirstlane(__builtin_bit_cast(int, diff_lambda(lq1, lk1, lq2, lk2, plane))));
        for (int uu = F.vcu; uu < 512; uu += F.G) {
            const int v = uu & 255, second = uu >> 8;
            const int bh = v >> 3, sidx = v & 7, qb = second ? 15 - sidx : sidx;
            const int b = bh >> 2, h = bh & 3;
            const size_t row0 = (size_t)b * SEQ + (size_t)qb * 128;
            att::attn_unit(Qb + row0 * DA + h * 128, Kb + (size_t)b * SEQ * DA + h * 128, Vb + (size_t)b * SEQ * DA + h * 128,
                           Y2 + row0 * DM + h * 128, qb * 128, alibi_slope2(h), lam, g_subln, (char*)lds + RING_OFF, MYTID());
        }
    }
    if constexpr (IN(3)) {
        PHASE_LANE(); KARGS();
        const float* state_conv = ap->in[4]; const float* w_dw = ap->in[15]; const float* b_dw = ap->in[16]; const float* ln_g = ap->in[17]; const float* ln_b = ap->in[18];
        bf16* Ub = WSP(bf16, WS_U); bf16* Y2 = WSP(bf16, WS_Y2);
        LAS float* wl = (LAS float*)(F.lds + RING_OFF);
        for (int i = ptid; i < CONV_WROWS * DC / 4; i += NWAVES * 64) { const int r = i / (DC / 4) - 3;
            ((LAS f32x4*)wl)[i] = (r >= 0 && r < CW) ? ((const GAS f32x4*)w_dw)[i - 3 * (DC / 4)] : (f32x4){0.f, 0.f, 0.f, 0.f}; }
        __syncthreads();
        for (int cu = F.vcu; cu < 256 + 4; cu += F.G) {
            if (cu < 256) { const int b = cu >> 5, blk = cu & 31;
                for (int gi = 0; gi < 2; ++gi) conv_group<0>(Ub, nullptr, nullptr, wl, b_dw, ln_g, ln_b, Y2, b, blk * 64 + F.wave * 8 + gi * 4, plane); }
            else { const int s = (cu - 256) * 8 + F.wave; conv_group<1>(Ub, state_conv, out + O_CS, wl, b_dw, ln_g, ln_b, Y2, s, 0, plane); }
        }
        __syncthreads();
    }
    if constexpr (IN(4)) { if (!DEC_FIRST) {
        KARGS();
        const float* cache_k = ap->in[2]; const float* cache_v = ap->in[3]; const int* page_table = (const int*)ap->in[5]; float* QS = WSP(float, WS_QS); float* DP = WSP(float, WS_DP);
        for (int du = F.vcu; du < DB * NH * DSPLIT; du += F.G) {
            const int s = du >> 3, h = (du >> 1) & 3, sp = du & 1;
            dec::decode_unit(QS, cache_k, cache_v, page_table, DP, s, h, sp, (LAS float*)(F.lds + RING_OFF), MYTID());
        }
    } }
    SEAM(4);

    if constexpr (IN(5)) {
        PHASE_LANE(); KARGS();
        const float* lq1 = ap->in[10]; const float* lk1 = ap->in[11]; const float* lq2 = ap->in[12]; const float* lk2 = ap->in[13]; const float* g_subln = ap->in[14];
        float* QS = WSP(float, WS_QS); float* DP = WSP(float, WS_DP); bf16* Y2 = WSP(bf16, WS_Y2);
        const float lam = diff_lambda(lq1, lk1, lq2, lk2, plane);
        for (int t = gw; t < DB * NH * DS; t += NGW) { const int s = t >> 4, h = (t >> 2) & 3, q = t & 3;
            dec::decode_finish(QS, out + O_KS, out + O_VS, DP, g_subln, lam, Y2, s, h, q, plane); }
    }
    SEAM(5);

    if constexpr (IN(6)) {
        KARGS();
        { PHASE_LANE();
          for (int it = F.vcu; it < DM / 16; it += F.G) { const int n0 = 16 * it;
              const f32x4 acc = skinny_acc((f32x4){0.f, 0.f, 0.f, 0.f}, WSP(bf16, WS_Y2) + (size_t)MP * DM, DM, WSP(bf16, WS_WOUT), DM, n0, 0, DM, F.wave, plane);
              float* o = WSP(float, WS_MM) + (size_t)(MP + 16 * F.wave + 4 * (plane >> 4)) * DM + n0 + (plane & 15);
#pragma unroll
              for (int r = 0; r < 4; ++r) o[(size_t)r * DM] = acc[r]; } }
        pg8::Gemm g{WSP(bf16, WS_Y2), WSP(bf16, WS_WOUT), MP, DM, ap->k_dm}; pg8::StaticOrder S; S.init(MP, DM, F.G, (int)blockIdx.x);
        EpiF32 E{WSP(float, WS_MM), DM};
        pg8::gemm_phase<EpiF32, pg8::StaticOrder, true, true>(F.lds + RING_OFF, g, S, E, MYTID());
    }
    SEAM(6);
    if constexpr (IN(7)) {
        PHASE_LANE(); KARGS();
        const float* x_p = ap->in[0]; const float* x_s = ap->in[1]; const float* g_post_mix = ap->in[20]; const float* g_pre_ffn = ap->in[21];
        float* MM = WSP(float, WS_MM); float* Hf = WSP(float, WS_H); bf16* HN = WSP(bf16, WS_HN);
        for (int m = gw; m < MR; m += NGW) post_mix_row(MM + (size_t)m * DM, x_row(x_p, x_s, m), g_post_mix, g_pre_ffn, Hf + (size_t)m * DM, HN + (size_t)m * DM, plane);
    }
    SEAM(7);
    if constexpr (IN(8)) {
        KARGS();
        { PHASE_LANE();
          for (int it = F.vcu; it < DFF / 16; it += F.G) { const int n0 = 16 * it;
              const f32x4 acc = skinny_acc((f32x4){0.f, 0.f, 0.f, 0.f}, WSP(bf16, WS_HN) + (size_t)MP * DM, DM, WSP(bf16, WS_WFF1), DM, n0, 0, DM, F.wave, plane);
              bf16* o = WSP(bf16, WS_HH) + (size_t)(MP + 16 * F.wave + 4 * (plane >> 4)) * DFF + n0 + (plane & 15);
#pragma unroll
              for (int r = 0; r < 4; ++r) { const float a = fmaxf(acc[r], 0.f); o[(size_t)r * DFF] = (bf16)f2bf(a * a); } } }
        pg8::Gemm g{WSP(bf16, WS_HN), WSP(bf16, WS_WFF1), MP, DFF, ap->k_dm}; pg8::StaticOrder S; S.init(MP, DFF, F.G, (int)blockIdx.x);
        EpiB16<1> E{WSP(bf16, WS_HH), DFF};
        pg8::gemm_phase<EpiB16<1>, pg8::StaticOrder, true, true>(F.lds + RING_OFF, g, S, E, MYTID());
    }
    SEAM(8);
    if constexpr (IN(9)) {
        KARGS();
        { PHASE_LANE();
          for (int it = F.vcu; it < (DM / 16) * FF2_KSPLIT; it += F.G) { const int n0 = 16 * (it >> 2), ks = it & 3;
              const f32x4 acc = skinny_acc((f32x4){0.f, 0.f, 0.f, 0.f}, WSP(bf16, WS_HH) + (size_t)MP * DFF, DFF, WSP(bf16, WS_WFF2), DFF, n0, ks * (DFF / FF2_KSPLIT), DFF / FF2_KSPLIT, F.wave, plane);
              float* o = WSP(float, WS_FFP) + ((size_t)ks * MS + 16 * F.wave + 4 * (plane >> 4)) * DM + n0 + (plane & 15);
#pragma unroll
              for (int r = 0; r < 4; ++r) o[(size_t)r * DM] = acc[r]; } }
        pg8::Gemm g{WSP(bf16, WS_HH), WSP(bf16, WS_WFF2), MP, DM, ap->k_ff}; pg8::StaticOrder S; S.init(MP, DM, F.G, (int)blockIdx.x);
        EpiF32 E{WSP(float, WS_FF), DM};
        pg8::gemm_phase<EpiF32, pg8::StaticOrder, true, true>(F.lds + RING_OFF, g, S, E, MYTID());
    }
    SEAM(9);
    if constexpr (IN(10)) {
        PHASE_LANE(); KARGS();
        const float* g_post_ffn = ap->in[22];
        float* FFo = WSP(float, WS_FF); float* Hf = WSP(float, WS_H); float* H2 = WSP(float, WS_H2); bf16* H2B = WSP(bf16, WS_H2B);
        for (int m = gw; m < MP; m += NGW) post_ffn_row<1>(FFo + (size_t)m * DM, 0, Hf + (size_t)m * DM, g_post_ffn, H2 + (size_t)m * DM, H2B + (size_t)m * DM, plane);
        for (int m = MP + gw; m < MR; m += NGW) post_ffn_row<FF2_KSPLIT>(WSP(float, WS_FFP) + (size_t)(m - MP) * DM, (size_t)MS * DM, Hf + (size_t)m * DM, g_post_ffn, H2 + (size_t)m * DM, H2B + (size_t)m * DM, plane);
    }
    SEAM(10);
    if constexpr (IN(11)) {
        KARGS();
        { PHASE_LANE();
          for (int it = F.vcu; it < DM / 16; it += F.G) { const int n0 = 16 * it;
              const f32x4 ag = skinny_acc((f32x4){0.f, 0.f, 0.f, 0.f}, WSP(bf16, WS_H2B) + (size_t)MP * DM, DM, WSP(bf16, WS_WGATE), DM, n0, 0, DM, F.wave, plane);
              const f32x4 ae = skinny_acc((f32x4){0.f, 0.f, 0.f, 0.f}, WSP(bf16, WS_PE) + (size_t)MP * DPLE, DPLE, WSP(bf16, WS_WPLE), DPLE, n0, 0, DPLE, F.wave, plane);
              const int r0 = 16 * F.wave + 4 * (plane >> 4), c = n0 + (plane & 15);
#pragma unroll
              for (int r = 0; r < 4; ++r) out[O_YS + (size_t)(r0 + r) * DM + c] = WSP(float, WS_H2)[(size_t)(MP + r0 + r) * DM + c] + sigmoidf_fast(ag[r]) * ae[r]; } }
        pg8::Gemm g{WSP(bf16, WS_H2B), WSP(bf16, WS_WGATE), MP, DM, ap->k_dm}; pg8::StaticOrder S; S.init(MP, DM, F.G, (int)blockIdx.x);
        EpiGate E{WSP(float, WS_H2), WSP(bf16, WS_E), out};
        pg8::gemm_phase<EpiGate, pg8::StaticOrder, true, true>(F.lds + RING_OFF, g, S, E, MYTID());
    }
#undef IN
#undef SEAM
}

#ifndef MK_N_LAUNCHES
#define MK_N_LAUNCHES 1
#endif
constexpr int NPH = 12;
template <int LO, int HI> static bool launch_range(int grid, const Args& a, hipStream_t stream) {
    static bool attr_set = false;
    if (!attr_set) { if (hipFuncSetAttribute((const void*)mk_fwd<LO, HI>, hipFuncAttributeMaxDynamicSharedMemorySize, LDS_BYTES) != hipSuccess) { fprintf(stderr, "kernel_launch: hipFuncSetAttribute failed\n"); return false; } attr_set = true; }
    hipLaunchKernelGGL((mk_fwd<LO, HI>), dim3(grid), dim3(NWAVES * 64), LDS_BYTES, stream, a);
    const hipError_t le = hipPeekAtLastError();
    if (le != hipSuccess) { fprintf(stderr, "kernel_launch: launch [%d,%d) failed: %s\n", LO, HI, hipGetErrorName(le)); return false; }
    return true;
}
extern "C" void kernel_launch(void* const* d_in, const int* in_sizes, int n_in, void* d_out, int out_size, void* d_ws, size_t ws_size, hipStream_t stream) {
    static int grid = 0;
    if (grid == 0) {
        if (n_in != 27 || in_sizes[0] != MP * DM || out_size != (int)O_END || ws_size < WS_END) {
            fprintf(stderr, "kernel_launch: unexpected problem shape: n_in %d in0 %d out %d ws %zu (need %zu)\n", n_in, n_in > 0 ? in_sizes[0] : -1, out_size, ws_size, (size_t)WS_END); grid = -1; return; }
        int dev = 0, cus = 0;
        if (hipGetDevice(&dev) != hipSuccess || hipDeviceGetAttribute(&cus, hipDeviceAttributeMultiprocessorCount, dev) != hipSuccess) { fprintf(stderr, "kernel_launch: device query failed\n"); grid = -1; return; }
        grid = cus;
    }
    if (grid < 0) return;
    if (hipMemsetAsync((char*)d_ws + WS_CTL, 0, CTL_ZERO_BYTES, stream) != hipSuccess) { fprintf(stderr, "kernel_launch: memset failed\n"); return; }
    Args a{};
    for (int i = 0; i < 27; ++i) a.in[i] = (const float*)d_in[i];
    a.out = (float*)d_out; a.ws = (unsigned char*)d_ws; a.k_dm = DM; a.k_ff = DFF; a.k_ple = DPLE; a.pad = 0;
#if MK_N_LAUNCHES == 1
    launch_range<0, 12>(grid, a, stream);
#else
    launch_range<0, 1>(grid, a, stream) && launch_range<1, 2>(grid, a, stream) && launch_range<2, 3>(grid, a, stream) && launch_range<3, 4>(grid, a, stream) &&
    launch_range<4, 5>(grid, a, stream) && launch_range<5, 6>(grid, a, stream) && launch_range<6, 7>(grid, a, stream) && launch_range<7, 8>(grid, a, stream) &&
    launch_range<8, 9>(grid, a, stream) && launch_range<9, 10>(grid, a, stream) && launch_range<10, 11>(grid, a, stream) && launch_range<11, 12>(grid, a, stream);
#endif
}
```
